# Optimizing an MI355X kernel written in HIP

```python
import math
import jax, jax.numpy as jnp
from jax import lax
import numpy as np

D_MODEL = 1024
BATCH = 16
SEQ = 4096
DEPTH = 1
DEC_BATCH = 2
DEC_SEQ = 8192
PAST_LEN = 128

D_RNN = D_MODEL
N_LRU_HEADS = 8
LRU_BLOCK = D_RNN // N_LRU_HEADS
LRU_C = 8.0
CONV_A_WIDTH = 4
CONV_A_LEFT = 2
D_FNET = D_MODEL // 2
N_FNET_GROUPS = 4
FNET_GROUP = D_FNET // N_FNET_GROUPS
D_FF = 2816
CONV_F_WIDTH = 3
CONV_F_LEFT = 1
N_MOD = 6
RMS_EPS = 1e-6
D_IN = 2 * D_RNN + D_FNET + 2 * D_MODEL

kernel_name = "hybrid_rglru_fnet_convffn_encoder"


def rms_norm(x, g):
    xf = x.astype(jnp.float32)
    y = xf * lax.rsqrt(jnp.mean(xf * xf, axis=-1, keepdims=True) + RMS_EPS)
    return (y * g.astype(jnp.float32)).astype(x.dtype)


def depthwise_conv(x, w, b, left):
    k_w = w.shape[0]
    s = x.shape[1]
    xp = jnp.pad(x, ((0, 0), (left, k_w - 1 - left), (0, 0)))
    out = b + xp[:, 0:s] * w[0]
    for k in range(1, k_w):
        out = out + xp[:, k:k + s] * w[k]
    return out


def _lru_combine(left, right):
    a_l, b_l = left
    a_r, b_r = right
    return (a_l * a_r, a_r * b_l + b_r)


def rg_lru(x, w_a, b_a, w_x, b_x, lam, reverse):
    bsz, s, w = x.shape
    xh = x.reshape(bsz, s, N_LRU_HEADS, LRU_BLOCK)
    r = jax.nn.sigmoid((jnp.einsum('bshi,hij->bshj', xh, w_a).reshape(bsz, s, w) + b_a).astype(jnp.float32))
    i = jax.nn.sigmoid((jnp.einsum('bshi,hij->bshj', xh, w_x).reshape(bsz, s, w) + b_x).astype(jnp.float32))
    log_a = -LRU_C * r * jax.nn.softplus(-lam.astype(jnp.float32))
    a = jnp.exp(log_a)
    mult = jnp.sqrt(jnp.maximum(-jnp.expm1(2.0 * log_a), 0.0))
    b = mult * i * x.astype(jnp.float32)
    _, h = lax.associative_scan(_lru_combine, (a, b), reverse=reverse, axis=1)
    return h.astype(x.dtype)


def fourier_mix(x):
    bsz, s, _ = x.shape
    xg = x.reshape(bsz, s, N_FNET_GROUPS, FNET_GROUP).astype(jnp.float32)
    f = jnp.fft.fft2(xg, axes=(1, 3), norm='ortho').real
    return f.reshape(bsz, s, D_FNET).astype(x.dtype)


def encoder_layer(x, c, w_ada, b_ada, g_pre_mix, w_in, conv_w, conv_b,
                  w_lru_a, b_lru_a, w_lru_x, b_lru_x, lru_lambda,
                  w_a_out, w_b_out, w_o, g_post_mix,
                  g_pre_ffn, w_up, ffn_conv_w, ffn_conv_b, w_down, g_post_ffn):
    mod = jax.nn.silu(c) @ w_ada + b_ada
    sh1, sc1, gt1, sh2, sc2, gt2 = [m[:, None, :] for m in jnp.split(mod, N_MOD, axis=-1)]

    h = rms_norm(x, g_pre_mix) * (1.0 + sc1) + sh1
    u = h @ w_in
    o1 = D_RNN
    o2 = o1 + D_RNN
    o3 = o2 + D_FNET
    o4 = o3 + D_MODEL
    xa, ya, xb, ga, gb = u[..., :o1], u[..., o1:o2], u[..., o2:o3], u[..., o3:o4], u[..., o4:]

    xa = depthwise_conv(xa, conv_w, conv_b, CONV_A_LEFT)
    h_fwd = rg_lru(xa, w_lru_a[0], b_lru_a[0], w_lru_x[0], b_lru_x[0], lru_lambda[0], reverse=False)
    h_bwd = rg_lru(xa, w_lru_a[1], b_lru_a[1], w_lru_x[1], b_lru_x[1], lru_lambda[1], reverse=True)
    y_a = ((h_fwd + h_bwd) * jax.nn.gelu(ya)) @ w_a_out

    y_b = fourier_mix(xb) @ w_b_out

    merged = jax.nn.sigmoid(ga) * y_a + jax.nn.sigmoid(gb) * y_b
    x = x + gt1 * rms_norm(merged @ w_o, g_post_mix)

    h = rms_norm(x, g_pre_ffn) * (1.0 + sc2) + sh2
    up = depthwise_conv(h @ w_up, ffn_conv_w, ffn_conv_b, CONV_F_LEFT)
    val, gate = up[..., :D_FF], up[..., D_FF:]
    f = (jax.nn.gelu(gate) * val) @ w_down
    x = x + gt2 * rms_norm(f, g_post_ffn)
    return x


def setup_inputs(seed: int = 0) -> dict:
    key = jax.random.key(seed)
    ks = jax.random.split(key, 32)
    f32 = jnp.float32
    nrm = lambda k, shape, scale: jax.random.normal(k, shape, f32) * scale
    p = jax.random.uniform(ks[13], (DEPTH, 2, D_RNN), f32, 0.9, 0.999)
    return {
        'x_prompt': nrm(ks[0], (BATCH, SEQ, D_MODEL), 1.0),
        'x_sample': nrm(ks[1], (DEC_BATCH, DEC_SEQ, D_MODEL), 1.0),
        'c_prompt': nrm(ks[2], (BATCH, D_MODEL), 1.0),
        'c_sample': nrm(ks[3], (DEC_BATCH, D_MODEL), 1.0),
        'w_ada': nrm(ks[4], (DEPTH, D_MODEL, N_MOD * D_MODEL), D_MODEL ** -0.5),
        'b_ada': nrm(ks[5], (DEPTH, N_MOD * D_MODEL), 0.02),
        'g_pre_mix': 1.0 + nrm(ks[6], (DEPTH, D_MODEL), 0.02),
        'w_in': nrm(ks[7], (DEPTH, D_MODEL, D_IN), D_MODEL ** -0.5),
        'conv_w': nrm(ks[8], (DEPTH, CONV_A_WIDTH, D_RNN), CONV_A_WIDTH ** -0.5),
        'conv_b': nrm(ks[9], (DEPTH, D_RNN), 0.02),
        'w_lru_a': nrm(ks[10], (DEPTH, 2, N_LRU_HEADS, LRU_BLOCK, LRU_BLOCK), LRU_BLOCK ** -0.5),
        'b_lru_a': nrm(ks[11], (DEPTH, 2, D_RNN), 0.02),
        'w_lru_x': nrm(ks[12], (DEPTH, 2, N_LRU_HEADS, LRU_BLOCK, LRU_BLOCK), LRU_BLOCK ** -0.5),
        'b_lru_x': nrm(ks[14], (DEPTH, 2, D_RNN), 0.02),
        'lru_lambda': jnp.log(p) - jnp.log1p(-p),
        'w_a_out': nrm(ks[15], (DEPTH, D_RNN, D_MODEL), D_RNN ** -0.5),
        'w_b_out': nrm(ks[16], (DEPTH, D_FNET, D_MODEL), D_FNET ** -0.5),
        'w_o': nrm(ks[17], (DEPTH, D_MODEL, D_MODEL), D_MODEL ** -0.5),
        'g_post_mix': 1.0 + nrm(ks[18], (DEPTH, D_MODEL), 0.02),
        'g_pre_ffn': 1.0 + nrm(ks[19], (DEPTH, D_MODEL), 0.02),
        'w_up': nrm(ks[20], (DEPTH, D_MODEL, 2 * D_FF), D_MODEL ** -0.5),
        'ffn_conv_w': nrm(ks[21], (DEPTH, CONV_F_WIDTH, 2 * D_FF), CONV_F_WIDTH ** -0.5),
        'ffn_conv_b': nrm(ks[22], (DEPTH, 2 * D_FF), 0.02),
        'w_down': nrm(ks[23], (DEPTH, D_FF, D_MODEL), D_FF ** -0.5),
        'g_post_ffn': 1.0 + nrm(ks[24], (DEPTH, D_MODEL), 0.02),
    }


def reference(x_prompt, x_sample, c_prompt, c_sample, w_ada, b_ada, g_pre_mix, w_in, conv_w, conv_b,
              w_lru_a, b_lru_a, w_lru_x, b_lru_x, lru_lambda, w_a_out, w_b_out, w_o, g_post_mix,
              g_pre_ffn, w_up, ffn_conv_w, ffn_conv_b, w_down, g_post_ffn):
    y_prompt = x_prompt
    y_sample = x_sample
    for l in range(DEPTH):
        layer_params = (w_ada[l], b_ada[l], g_pre_mix[l], w_in[l], conv_w[l], conv_b[l],
                        w_lru_a[l], b_lru_a[l], w_lru_x[l], b_lru_x[l], lru_lambda[l],
                        w_a_out[l], w_b_out[l], w_o[l], g_post_mix[l],
                        g_pre_ffn[l], w_up[l], ffn_conv_w[l], ffn_conv_b[l], w_down[l], g_post_ffn[l])
        y_prompt = encoder_layer(y_prompt, c_prompt, *layer_params)
        y_sample = encoder_layer(y_sample, c_sample, *layer_params)
    return (y_prompt, y_sample)
```

```cpp
#include <hip/hip_runtime.h>
#include <hip/hip_cooperative_groups.h>
#include <cstdio>
namespace cg = cooperative_groups;
namespace pg8 {
#define PG8_LAS __attribute__((address_space(3)))
typedef unsigned short bf16_t;
typedef short bf16x8 __attribute__((ext_vector_type(8)));
typedef float f32x4 __attribute__((ext_vector_type(4)));
typedef unsigned u32x4 __attribute__((ext_vector_type(4)));
constexpr int BM = 256, BK = 64, HALF = 128, HTB = HALF * BK * 2  , STAGE_BYTES = 8 * HTB, NXCD = 8, WGM = 8;

__host__ __device__ __forceinline__ int lds_byte(int r, int c) { const int st = (r >> 4) * 2 + (c >> 5), rr = r & 15, cc = c & 31, ob = rr * 64 + cc * 2; return st * 1024 + (ob ^ (((ob >> 9) & 1) << 5)); }
__host__ __device__ __forceinline__ void stage_rc(int b, int& R, int& C) { const int st = b / 1024, sb = b % 1024, swz = sb ^ (((sb >> 9) & 1) << 5); R = (st >> 1) * 16 + swz / 64; C = (st & 1) * 32 + (swz % 64) / 2; }
__host__ __device__ __forceinline__ int perm32(int rho) { const int n = rho >> 4, i = rho & 15; return 8 * (i >> 2) + 4 * n + (i & 3); }

struct Unit { int pm, pn; };
struct Gemm { const bf16_t* A; const bf16_t* Bt; int M, N, K; };

struct StaticOrder {
    int nM, nN, nwg, G, c;
    __host__ __device__ void init(int M, int N, int G_, int c_) { nM = M / BM; nN = N / BM; nwg = nM * nN; G = G_; c = c_; }
    __host__ __device__ bool next(int i, Unit& u) const {
        const long L = (long)i * G + c; if (L >= nwg) return false;
        int wgid = (int)L; { const int q = nwg / NXCD, r = nwg % NXCD, xcd = wgid % NXCD, off = wgid / NXCD; wgid = (xcd < r ? xcd * (q + 1) : r * (q + 1) + (xcd - r) * q) + off; }
        const int nig = WGM * nN, gid = wgid / nig, fm = gid * WGM, gsz = (nM - fm) < WGM ? (nM - fm) : WGM;
        u.pm = fm + ((wgid % nig) % gsz); u.pn = (wgid % nig) / gsz; return true;
    }
    __device__ __forceinline__ void a_ready(const Unit&) const {}
    __device__ __forceinline__ void done(const Unit&) const {}
};
__device__ __forceinline__ unsigned cvt_pk_bf16(float lo, float hi) { unsigned r; asm volatile("v_cvt_pk_bf16_f32 %0, %1, %2" : "=v"(r) : "v"(lo), "v"(hi)); return r; }
typedef float f32x2 __attribute__((ext_vector_type(2)));
template <class Epi, class Sched, bool STAMP = false>
__device__ __forceinline__ void gemm_phase(PG8_LAS unsigned char* lds, const Gemm g, const Sched& S, const Epi& E, unsigned long long* stamps) {
    const int tid = threadIdx.x, wid = __builtin_amdgcn_readfirstlane(tid >> 6), lane = tid & 63, wr = wid >> 2, wc = wid & 3, fr = lane & 15, fq = lane >> 4;
    const int K = g.K, nt = K / BK;
    int ts_lo = 0, ts_hi = 0, nts = 0; const unsigned long long rt_entry = STAMP ? (unsigned long long)wall_clock64() : 0ull;
#define PG8_STAMP() do { if (STAMP && wid == 0 && nts < 64) { const unsigned long long _c = (unsigned long long)clock64(); \
        ts_lo = (lane == nts) ? (int)(unsigned)_c : ts_lo; ts_hi = (lane == nts) ? (int)(unsigned)(_c >> 32) : ts_hi; ++nts; } } while (0)
    PG8_STAMP();
    unsigned voffA[2], voffB[2];
#pragma unroll
    for (int i = 0; i < 2; ++i) { int R, C; stage_rc(tid * 16 + i * 8192, R, C); const int Rb = Epi::PERM ? ((R & ~31) + perm32(R & 31)) : R;
        voffA[i] = (unsigned)(R * K + C) * 2u; voffB[i] = (unsigned)(Rb * K + C) * 2u; }
    const size_t kstep = (size_t)(BK * 2);
    const size_t hstep = (size_t)HALF * K * 2;
    const size_t tstep = 2 * hstep;
    const unsigned ldsw = (unsigned)wid * 1024u;
    const int aoff = lds_byte(wr * 64 + fr, fq * 8), boff = lds_byte(wc * 32 + fr, fq * 8);
#define PG8_SA(b, h) (((b) * 2 + (h)) * HTB)
#define PG8_SB(b, h) ((4 + (b) * 2 + (h)) * HTB)
#define PG8_STAGE(bufoff, gbase, voff) do { _Pragma("unroll") for (int _i = 0; _i < 2; ++_i) \
        __builtin_amdgcn_global_load_lds((const unsigned*)((const char*)(gbase) + (voff)[_i]), (PG8_LAS unsigned*)(lds + (bufoff) + ldsw + _i * 8192), 16, 0, 0); } while (0)
#define PG8_LDA(dst, b, h) do { _Pragma("unroll") for (int m = 0; m < 4; ++m) _Pragma("unroll") for (int k = 0; k < 2; ++k) dst[m][k] = *(const PG8_LAS bf16x8*)(lds + PG8_SA(b, h) + aoff + m * 2048 + k * 1024); } while (0)
#define PG8_LDB(dst, b, h) do { _Pragma("unroll") for (int n = 0; n < 2; ++n) _Pragma("unroll") for (int k = 0; k < 2; ++k) dst[n][k] = *(const PG8_LAS bf16x8*)(lds + PG8_SB(b, h) + boff + n * 2048 + k * 1024); } while (0)
#define PG8_MMA(ai, bj, At, Bt) do { __builtin_amdgcn_s_setprio(1); _Pragma("unroll") for (int m = 0; m < 4; ++m) _Pragma("unroll") for (int n = 0; n < 2; ++n) _Pragma("unroll") for (int k = 0; k < 2; ++k) \
        acc[ai][bj][m][n] = __builtin_amdgcn_mfma_f32_16x16x32_bf16(Bt[n][k], At[m][k], acc[ai][bj][m][n], 0, 0, 0); __builtin_amdgcn_s_setprio(0); } while (0)
#define PG8_WAIT_V(n) asm volatile("s_waitcnt vmcnt(" #n ")" ::: "memory")
#define PG8_WAIT_L(n) asm volatile("s_waitcnt lgkmcnt(" #n ")" ::: "memory")
#define PG8_BAR __builtin_amdgcn_s_barrier()
#define PG8_SCHED __builtin_amdgcn_sched_barrier(0)
    Unit cur, nxt; int ui = 0;
    if (!S.next(0, cur)) return;
    f32x4 acc[2][2][4][2];
#pragma unroll
    for (int a = 0; a < 2; ++a)
#pragma unroll
        for (int b = 0; b < 2; ++b)
#pragma unroll
            for (int m = 0; m < 4; ++m)
#pragma unroll
                for (int n = 0; n < 2; ++n) acc[a][b][m][n] = (f32x4){0.f, 0.f, 0.f, 0.f};
    bf16x8 At[4][2], B0[2][2], B1[2][2];
    const char* cA = (const char*)g.A + (size_t)cur.pm * tstep; const char* cB = (const char*)g.Bt + (size_t)cur.pn * tstep;
    S.a_ready(cur);
    PG8_STAGE(PG8_SB(0, 0), cB, voffB); PG8_STAGE(PG8_SA(0, 0), cA, voffA); PG8_STAGE(PG8_SB(0, 1), cB + hstep, voffB); PG8_STAGE(PG8_SA(0, 1), cA + hstep, voffA);
    if (wr == 1) PG8_BAR;
    PG8_WAIT_V(4); PG8_BAR;
    PG8_STAGE(PG8_SB(1, 0), cB + kstep, voffB); PG8_STAGE(PG8_SA(1, 0), cA + kstep, voffA); PG8_STAGE(PG8_SB(1, 1), cB + hstep + kstep, voffB);
    PG8_WAIT_V(6); PG8_BAR;
    PG8_STAMP();
    for (;;) {
        const bool has_next = S.next(ui + 1, nxt);
        const char* nA = has_next ? (const char*)g.A + (size_t)nxt.pm * tstep : cA; const char* nB = has_next ? (const char*)g.Bt + (size_t)nxt.pn * tstep : cB;
        for (int t = 0; t < nt; t += 2) {
            const bool last = (t == nt - 2);
            const char* a1 = cA + (size_t)(t + 1) * kstep;
            const char* a2 = last ? nA : cA + (size_t)(t + 2) * kstep; const char* b2 = last ? nB : cB + (size_t)(t + 2) * kstep;
            const char* a3 = a2 + kstep; const char* b3 = b2 + kstep;
            if (last && has_next) S.a_ready(nxt);
            PG8_LDB(B0, 0, 0); PG8_SCHED; PG8_LDA(At, 0, 0); PG8_STAGE(PG8_SA(1, 1), a1 + hstep, voffA);
            PG8_WAIT_L(8); PG8_BAR; PG8_WAIT_L(0); PG8_MMA(0, 0, At, B0); PG8_BAR; PG8_SCHED;
            PG8_LDB(B1, 0, 1); PG8_STAGE(PG8_SB(0, 0), b2, voffB);
            PG8_BAR; PG8_WAIT_L(0); PG8_MMA(0, 1, At, B1); PG8_BAR;
            PG8_LDA(At, 0, 1); PG8_STAGE(PG8_SA(0, 0), a2, voffA);
            PG8_BAR; PG8_WAIT_L(0); PG8_MMA(1, 0, At, B0); PG8_BAR; PG8_SCHED;
            PG8_STAGE(PG8_SB(0, 1), b2 + hstep, voffB);
            PG8_WAIT_V(6); PG8_BAR; PG8_MMA(1, 1, At, B1); PG8_BAR;
            PG8_LDB(B0, 1, 0); PG8_SCHED; PG8_LDA(At, 1, 0); PG8_STAGE(PG8_SA(0, 1), a2 + hstep, voffA);
            PG8_WAIT_L(8); PG8_BAR; PG8_WAIT_L(0); PG8_MMA(0, 0, At, B0); PG8_BAR; PG8_SCHED;
            PG8_LDB(B1, 1, 1); PG8_STAGE(PG8_SB(1, 0), b3, voffB);
            PG8_BAR; PG8_WAIT_L(0); PG8_MMA(0, 1, At, B1); PG8_BAR;
            PG8_LDA(At, 1, 1); PG8_STAGE(PG8_SA(1, 0), a3, voffA);
            PG8_BAR; PG8_WAIT_L(0); PG8_MMA(1, 0, At, B0); PG8_BAR; PG8_SCHED;
            PG8_STAGE(PG8_SB(1, 1), b3 + hstep, voffB);
            PG8_WAIT_V(6); PG8_BAR; PG8_MMA(1, 1, At, B1); PG8_BAR;
        }
        PG8_STAMP();
        if constexpr (!Epi::AFTER_DRAIN) { E(acc, cur, wr, wc, fr, fq); S.done(cur); }
        PG8_STAMP();
        if (!has_next) break;
#pragma unroll
        for (int a = 0; a < 2; ++a)
#pragma unroll
            for (int b = 0; b < 2; ++b)
#pragma unroll
                for (int m = 0; m < 4; ++m)
#pragma unroll
                    for (int n = 0; n < 2; ++n) acc[a][b][m][n] = (f32x4){0.f, 0.f, 0.f, 0.f};
        cur = nxt; cA = nA; cB = nB; ++ui;
    }
    PG8_WAIT_V(0);
    if (wr == 0) PG8_BAR;
    PG8_BAR;
    if constexpr (Epi::AFTER_DRAIN) { E.fused(acc, cur, wr, wc, fr, fq, lds, wid, lane); S.done(cur); }
    PG8_STAMP();
    if (STAMP && wid == 0) { stamps[lane] = lane < nts ? (((unsigned long long)(unsigned)ts_hi << 32) | (unsigned)ts_lo) : 0ull;
        if (lane == 62) stamps[62] = rt_entry; if (lane == 63) stamps[63] = (unsigned long long)wall_clock64(); }
#undef PG8_STAMP
#undef PG8_SA
#undef PG8_SB
#undef PG8_STAGE
#undef PG8_LDA
#undef PG8_LDB
#undef PG8_MMA
#undef PG8_WAIT_V
#undef PG8_WAIT_L
#undef PG8_BAR
#undef PG8_SCHED
}
}
using pg8::bf16_t; using pg8::bf16x8; using pg8::f32x4; using pg8::cvt_pk_bf16;
#define LAS __attribute__((address_space(3)))
typedef unsigned u32x2v __attribute__((ext_vector_type(2)));
typedef unsigned u32x4v __attribute__((ext_vector_type(4)));

constexpr int NTOK = 81920, NPR = 65536;
constexpr int LDS_BYTES = 147456;
constexpr float RMS_EPS = 1e-6f;

constexpr size_t OFF_WIN = 0, OFF_WG = OFF_WIN + 5120ull * 1024 * 2, OFF_WA = OFF_WG + 8ull * 512 * 128 * 2, OFF_WB = OFF_WA + 1024ull * 1024 * 2,
    OFF_WO = OFF_WB + 1024ull * 512 * 2, OFF_WUP = OFF_WO + 1024ull * 1024 * 2, OFF_WD = OFF_WUP + 5632ull * 1024 * 2, OFF_DA1 = OFF_WD + 1024ull * 2816 * 2,
    OFF_DA3S = OFF_DA1 + 128 * 128 * 2, OFF_DA3L = OFF_DA3S + 64 * 128 * 2, OFF_TW4 = OFF_DA3L + 128 * 256 * 2, OFF_TW8 = OFF_TW4 + 4096 * 8, OFF_MOD = OFF_TW8 + 8192 * 8,
    OFF_ST1 = OFF_MOD + 18 * 6144 * 4, OFF_ST2 = OFF_ST1 + NTOK * 4, OFF_AGG = OFF_ST2 + NTOK * 4, OFF_CAR = OFF_AGG + 640ull * 2 * 1024 * 8, OFF_SMALL_END = OFF_CAR + 640ull * 2 * 1024 * 4;
constexpr size_t OFF_BIG = 67108864ull, REG_BYTES = (size_t)NTOK * 1024 * 2;
static_assert(OFF_SMALL_END <= OFF_BIG, "small region overflow");
#define REG(i) (OFF_BIG + (size_t)(i) * REG_BYTES)

struct Params {
    const float *x_prompt, *x_sample, *c_prompt, *c_sample, *w_ada, *b_ada, *g_pre_mix, *w_in, *conv_w, *conv_b, *w_lru_a, *b_lru_a, *w_lru_x, *b_lru_x, *lru_lambda,
        *w_a_out, *w_b_out, *w_o, *g_post_mix, *g_pre_ffn, *w_up, *ffn_conv_w, *ffn_conv_b, *w_down, *g_post_ffn;
    float* out; unsigned char* ws; int ph_lo, ph_hi;
};

__device__ __forceinline__ float bf2f(unsigned v) { return __uint_as_float(v << 16); }
__device__ __forceinline__ float bflo(unsigned v) { return __uint_as_float(v << 16); }
__device__ __forceinline__ float bfhi(unsigned v) { return __uint_as_float(v & 0xffff0000u); }
__device__ __forceinline__ bf16_t f2bf(float f) { unsigned u = __float_as_uint(f); u += 0x7FFFu + ((u >> 16) & 1u); return (bf16_t)(u >> 16); }
__device__ __forceinline__ float sigm(float x) { return __builtin_amdgcn_rcpf(1.0f + __expf(-x)); }
__device__ __forceinline__ float gelu_t(float x) { return x * sigm(1.5957691216057308f * (x + 0.044715f * x * x * x)); }
__device__ __forceinline__ float wave_sum(float v) {
#pragma unroll
    for (int o = 32; o >= 1; o >>= 1) v += __shfl_xor(v, o);
    return v;
}
__device__ __forceinline__ int seq_of_tok(int tok) { return tok < NPR ? (tok >> 12) : 16 + ((tok - NPR) >> 13); }
__device__ __forceinline__ const float* xrow(const Params& p, int tok) { return tok < NPR ? p.x_prompt + (size_t)tok * 1024 : p.x_sample + (size_t)(tok - NPR) * 1024; }

__device__ __forceinline__ int klog_of(int pp) { return 32 * (pp >> 5) + (pp & 3) + 4 * ((pp >> 3) & 3) + 16 * ((pp >> 2) & 1); }

__device__ void transpose_tile(const float* __restrict__ src, int ld, int sc0, int k0, bf16_t* __restrict__ dst, int K, int dr0, LAS float* tile) {
    const int t = threadIdx.x;
    {
        const int r = t >> 4, c4 = t & 15;
#pragma unroll
        for (int i = 0; i < 2; ++i) {
            const float4 v = *(const float4*)(src + (size_t)(k0 + r + 32 * i) * ld + sc0 + 4 * c4);
            LAS float* d = tile + (r + 32 * i) * 65 + 4 * c4; d[0] = v.x; d[1] = v.y; d[2] = v.z; d[3] = v.w;
        }
    }
    __syncthreads();
    {
        const int n = t >> 3, kc = t & 7; float f[8];
#pragma unroll
        for (int j = 0; j < 8; ++j) f[j] = tile[(8 * kc + j) * 65 + n];
        u32x4v o; o.x = cvt_pk_bf16(f[0], f[1]); o.y = cvt_pk_bf16(f[2], f[3]); o.z = cvt_pk_bf16(f[4], f[5]); o.w = cvt_pk_bf16(f[6], f[7]);
        *(u32x4v*)(dst + (size_t)(dr0 + n) * K + k0 + 8 * kc) = o;
    }
    __syncthreads();
}

__device__ void prep_phase(const Params& p, LAS unsigned char* lds) {
    const int tid = threadIdx.x;
    unsigned char* ws = p.ws;
    bf16_t* WinT = (bf16_t*)(ws + OFF_WIN);
    {
        const int gtid = blockIdx.x * 512 + tid, gsz = gridDim.x * 512;
        bf16_t* A1 = (bf16_t*)(ws + OFF_DA1); bf16_t* A3S = (bf16_t*)(ws + OFF_DA3S); bf16_t* A3L = (bf16_t*)(ws + OFF_DA3L);
        for (int i = gtid; i < 128 * 128; i += gsz) {
            const int row = i >> 7, pp = i & 127, kl = klog_of(pp), k1 = row >> 1, po = row & 1, pin = kl >> 6, s1 = kl & 63;
            float s, c; sincospif((float)((k1 * s1) & 63) * (1.0f / 32.0f), &s, &c);
            const float v = po == 0 ? (pin == 0 ? c : s) : (pin == 0 ? -s : c);
            A1[i] = f2bf(v);
        }
        for (int i = gtid; i < 64 * 128; i += gsz) {
            const int k2 = i >> 7, pp = i & 127, kl = klog_of(pp), pin = kl >> 6, s2 = kl & 63;
            float s, c; sincospif((float)((k2 * s2) & 63) * (1.0f / 32.0f), &s, &c);
            A3S[i] = f2bf(pin == 0 ? c : s);
        }
        for (int i = gtid; i < 128 * 256; i += gsz) {
            const int k2 = i >> 8, pp = i & 255, kl = klog_of(pp), pin = kl >> 7, s2 = kl & 127;
            float s, c; sincospif((float)((k2 * s2) & 127) * (1.0f / 64.0f), &s, &c);
            A3L[i] = f2bf(pin == 0 ? c : s);
        }
        float2* tw4 = (float2*)(ws + OFF_TW4); float2* tw8 = (float2*)(ws + OFF_TW8);
        for (int i = gtid; i < 4096; i += gsz) { float s, c; sincospif((float)i * (1.0f / 2048.0f), &s, &c); tw4[i] = make_float2(c, s); }
        for (int i = gtid; i < 8192; i += gsz) { float s, c; sincospif((float)i * (1.0f / 4096.0f), &s, &c); tw8[i] = make_float2(c, s); }
        float* st = (float*)(ws + OFF_ST1);
        for (int i = gtid; i < 2 * NTOK; i += gsz) st[i] = 0.f;
    }
    constexpr int N_MOD = 96, N_Z = 64, N_TR = 3904;
    for (int it = blockIdx.x; it < N_MOD + N_Z + N_TR; it += gridDim.x) {
        if (it < N_MOD) {
            LAS float* sc = (LAS float*)lds;
            LAS float* red = (LAS float*)(lds + 73728);
            for (int i = tid; i < 18 * 1024; i += 512) { const int b = i >> 10, k = i & 1023; const float c = b < 16 ? p.c_prompt[b * 1024 + k] : p.c_sample[(b - 16) * 1024 + k]; sc[i] = c * sigm(c); }
            __syncthreads();
            const int col = tid & 63, kg = tid >> 6, n0 = it * 64;
            float acc[18];
#pragma unroll
            for (int b = 0; b < 18; ++b) acc[b] = 0.f;
#pragma unroll 4
            for (int i = 0; i < 128; ++i) {
                const int k = kg * 128 + i; const float w = p.w_ada[(size_t)k * 6144 + n0 + col];
#pragma unroll
                for (int b = 0; b < 18; ++b) acc[b] += sc[b * 1024 + k] * w;
            }
#pragma unroll
            for (int b = 0; b < 18; ++b) red[(kg * 18 + b) * 64 + col] = acc[b];
            __syncthreads();
            float* mod = (float*)(ws + OFF_MOD);
            for (int i = tid; i < 18 * 64; i += 512) { const int b = i >> 6, c = i & 63; float s = p.b_ada[n0 + c];
#pragma unroll
                for (int g = 0; g < 8; ++g) s += red[(g * 18 + b) * 64 + c];
                mod[b * 6144 + n0 + c] = s; }
            __syncthreads();
        } else if (it < N_MOD + N_Z) {
            const int zi = it - N_MOD, g = zi >> 4, k0 = (zi & 15) * 64;
            LAS float* wt = (LAS float*)lds;
            LAS float* tc = (LAS float*)(lds + 64 * 129 * 4); LAS float* tsn = tc + 128;
#pragma unroll
            for (int i = 0; i < 4; ++i) { const int idx = tid + 512 * i, r = idx >> 5, c4 = idx & 31;
                const float4 v = *(const float4*)(p.w_in + (size_t)(k0 + r) * 4608 + 2048 + g * 128 + 4 * c4);
                LAS float* d = wt + r * 129 + 4 * c4; d[0] = v.x; d[1] = v.y; d[2] = v.z; d[3] = v.w; }
            if (tid < 128) { float s, c; sincospif((float)tid * (1.0f / 64.0f), &s, &c); tc[tid] = c; tsn[tid] = s; }
            __syncthreads();
            const int kin = tid & 63, mg = tid >> 6;
            for (int mi = 0; mi < 16; ++mi) { const int m = mg * 16 + mi; float aC = 0.f, aS = 0.f;
#pragma unroll 8
                for (int c = 0; c < 128; ++c) { const float w = wt[kin * 129 + c]; const int q = (m * c) & 127; aC += w * tc[q]; aS += w * tsn[q]; }
                WinT[(size_t)(2048 + g * 128 + m) * 1024 + k0 + kin] = f2bf(aC);
                WinT[(size_t)(2560 + g * 128 + m) * 1024 + k0 + kin] = f2bf(-aS); }
            __syncthreads();
        } else {
            int j = it - N_MOD - N_Z; LAS float* tile = (LAS float*)lds;
            if (j < 512) { const int kt = j & 15, nt = j >> 4; transpose_tile(p.w_in, 4608, nt * 64, kt * 64, WinT, 1024, nt * 64, tile); continue; } j -= 512;
            if (j < 512) { const int kt = j & 15, nt = j >> 4; transpose_tile(p.w_in, 4608, 2560 + nt * 64, kt * 64, WinT, 1024, 3072 + nt * 64, tile); continue; } j -= 512;
            if (j < 256) { const int kt = j & 15, nt = j >> 4; transpose_tile(p.w_a_out, 1024, nt * 64, kt * 64, (bf16_t*)(ws + OFF_WA), 1024, nt * 64, tile); continue; } j -= 256;
            if (j < 128) { const int kt = j & 7, nt = j >> 3; transpose_tile(p.w_b_out, 1024, nt * 64, kt * 64, (bf16_t*)(ws + OFF_WB), 512, nt * 64, tile); continue; } j -= 128;
            if (j < 256) { const int kt = j & 15, nt = j >> 4; transpose_tile(p.w_o, 1024, nt * 64, kt * 64, (bf16_t*)(ws + OFF_WO), 1024, nt * 64, tile); continue; } j -= 256;
            if (j < 1408) { const int kt = j & 15, nt = j >> 4, t256 = nt >> 2, sub = nt & 3, half = sub >> 1, jj0 = (sub & 1) * 64;
                transpose_tile(p.w_up, 5632, half * 2816 + 128 * t256 + jj0, kt * 64, (bf16_t*)(ws + OFF_WUP), 1024, nt * 64, tile); continue; } j -= 1408;
            if (j < 704) { const int kt = j % 44, nt = j / 44; transpose_tile(p.w_down, 1024, nt * 64, kt * 64, (bf16_t*)(ws + OFF_WD), 2816, nt * 64, tile); continue; } j -= 704;
            { const int mat = j >> 2, kt = j & 1, nt = (j >> 1) & 1, hd = mat & 7, which = (mat >> 3) & 1, dir = mat >> 4;
              const float* src = (which ? p.w_lru_x : p.w_lru_a) + (size_t)(dir * 8 + hd) * 128 * 128;
              transpose_tile(src, 128, nt * 64, kt * 64, (bf16_t*)(ws + OFF_WG), 128, hd * 512 + (dir * 2 + which) * 128 + nt * 64, tile); }
        }
    }
}

__device__ void h1_phase(const Params& p) {
    const int lane = threadIdx.x & 63, w = threadIdx.x >> 6;
    const float* mod = (const float*)(p.ws + OFF_MOD); bf16_t* h1 = (bf16_t*)p.out;
    for (int row = blockIdx.x * 8 + w; row < NTOK; row += gridDim.x * 8) {
        const float* x = xrow(p, row); const float* md = mod + seq_of_tok(row) * 6144;
        float4 v[4]; float ss = 0.f;
#pragma unroll
        for (int i = 0; i < 4; ++i) { v[i] = *(const float4*)(x + 4 * (lane + 64 * i)); ss += v[i].x * v[i].x + v[i].y * v[i].y + v[i].z * v[i].z + v[i].w * v[i].w; }
        ss = wave_sum(ss); const float rs = rsqrtf(ss * (1.0f / 1024.0f) + RMS_EPS);
#pragma unroll
        for (int i = 0; i < 4; ++i) { const int c = 4 * (lane + 64 * i);
            const float4 g = *(const float4*)(p.g_pre_mix + c), sh = *(const float4*)(md + c), sc = *(const float4*)(md + 1024 + c);
            u32x2v o; o.x = cvt_pk_bf16(v[i].x * rs * g.x * (1.f + sc.x) + sh.x, v[i].y * rs * g.y * (1.f + sc.y) + sh.y);
            o.y = cvt_pk_bf16(v[i].z * rs * g.z * (1.f + sc.z) + sh.z, v[i].w * rs * g.w * (1.f + sc.w) + sh.w);
            *(u32x2v*)(h1 + (size_t)row * 1024 + c) = o; }
    }
}
__device__ void x1_phase(const Params& p) {
    const int lane = threadIdx.x & 63, w = threadIdx.x >> 6;
    const float* mod = (const float*)(p.ws + OFF_MOD); const float* st1 = (const float*)(p.ws + OFF_ST1);
    const bf16_t* mo = (const bf16_t*)(p.ws + REG(2)); bf16_t* h2 = (bf16_t*)(p.ws + REG(0));
    for (int row = blockIdx.x * 8 + w; row < NTOK; row += gridDim.x * 8) {
        const float* x = xrow(p, row); const float* md = mod + seq_of_tok(row) * 6144;
        const float rs1 = rsqrtf(st1[row] * (1.0f / 1024.0f) + RMS_EPS);
        float4 v[4]; float ss = 0.f;
#pragma unroll
        for (int i = 0; i < 4; ++i) { const int c = 4 * (lane + 64 * i); v[i] = *(const float4*)(x + c);
            const u32x2v m = *(const u32x2v*)(mo + (size_t)row * 1024 + c); const float4 g = *(const float4*)(p.g_post_mix + c), gt = *(const float4*)(md + 2048 + c);
            v[i].x += gt.x * g.x * rs1 * bflo(m.x); v[i].y += gt.y * g.y * rs1 * bfhi(m.x); v[i].z += gt.z * g.z * rs1 * bflo(m.y); v[i].w += gt.w * g.w * rs1 * bfhi(m.y);
            *(float4*)(p.out + (size_t)row * 1024 + c) = v[i];
            ss += v[i].x * v[i].x + v[i].y * v[i].y + v[i].z * v[i].z + v[i].w * v[i].w; }
        ss = wave_sum(ss); const float rs = rsqrtf(ss * (1.0f / 1024.0f) + RMS_EPS);
#pragma unroll
        for (int i = 0; i < 4; ++i) { const int c = 4 * (lane + 64 * i);
            const float4 g = *(const float4*)(p.g_pre_ffn + c), sh = *(const float4*)(md + 3072 + c), sc = *(const float4*)(md + 4096 + c);
            u32x2v o; o.x = cvt_pk_bf16(v[i].x * rs * g.x * (1.f + sc.x) + sh.x, v[i].y * rs * g.y * (1.f + sc.y) + sh.y);
            o.y = cvt_pk_bf16(v[i].z * rs * g.z * (1.f + sc.z) + sh.z, v[i].w * rs * g.w * (1.f + sc.w) + sh.w);
            *(u32x2v*)(h2 + (size_t)row * 1024 + c) = o; }
    }
}
__device__ void final_phase(const Params& p) {
    const int lane = threadIdx.x & 63, w = threadIdx.x >> 6;
    const float* mod = (const float*)(p.ws + OFF_MOD); const float* st2 = (const float*)(p.ws + OFF_ST2);
    const bf16_t* f = (const bf16_t*)(p.ws + REG(1));
    for (int row = blockIdx.x * 8 + w; row < NTOK; row += gridDim.x * 8) {
        const float* md = mod + seq_of_tok(row) * 6144; const float rs = rsqrtf(st2[row] * (1.0f / 1024.0f) + RMS_EPS);
#pragma unroll
        for (int i = 0; i < 4; ++i) { const int c = 4 * (lane + 64 * i); float4 v = *(const float4*)(p.out + (size_t)row * 1024 + c);
            const u32x2v m = *(const u32x2v*)(f + (size_t)row * 1024 + c); const float4 g = *(const float4*)(p.g_post_ffn + c), gt = *(const float4*)(md + 5120 + c);
            v.x += gt.x * g.x * rs * bflo(m.x); v.y += gt.y * g.y * rs * bfhi(m.x); v.z += gt.z * g.z * rs * bflo(m.y); v.w += gt.w * g.w * rs * bfhi(m.y);
            *(float4*)(p.out + (size_t)row * 1024 + c) = v; }
    }
}

#define EPI_LOOP_ROWS for (int ai = 0; ai < 2; ++ai) _Pragma("unroll") for (int m = 0; m < 4; ++m)
__device__ __forceinline__ u32x4v pack8(const f32x4 a, const f32x4 b) { u32x4v o; o.x = cvt_pk_bf16(a[0], a[1]); o.y = cvt_pk_bf16(a[2], a[3]); o.z = cvt_pk_bf16(b[0], b[1]); o.w = cvt_pk_bf16(b[2], b[3]); return o; }

struct EpiIn {
    static constexpr bool PERM = true, AFTER_DRAIN = false; unsigned char* ws;
    __device__ __forceinline__ void operator()(const f32x4 (&acc)[2][2][4][2], const pg8::Unit& u, int wr, int wc, int fr, int fq) const {
        const int pn = u.pn, tok0 = u.pm * 256; bf16_t* tb; int ld;
        if (pn < 4) { tb = (bf16_t*)(ws + REG(0)) + (size_t)tok0 * 1024 + pn * 256; ld = 1024; }
        else if (pn < 8) { tb = (bf16_t*)(ws + REG(1)) + (size_t)tok0 * 1024 + (pn - 4) * 256; ld = 1024; }
        else if (pn < 12) { const int plane = (pn - 8) >> 1, ct = ((pn - 8) & 1) * 256; int S, s0; if (tok0 < NPR) { S = 4096; s0 = tok0 & 4095; } else { S = 8192; s0 = (tok0 - NPR) & 8191; }
            tb = (bf16_t*)(ws + REG(4)) + (size_t)(tok0 - s0) * 1024 + (size_t)plane * S * 512 + (size_t)s0 * 512 + ct; ld = 512; }
        else if (pn < 16) { tb = (bf16_t*)(ws + REG(2)) + (size_t)tok0 * 1024 + (pn - 12) * 256; ld = 1024; }
        else { tb = (bf16_t*)(ws + REG(3)) + (size_t)tok0 * 1024 + (pn - 16) * 256; ld = 1024; }
        tb += (size_t)(wr * 64 + fr) * ld + wc * 32 + 8 * fq;
#pragma unroll
        EPI_LOOP_ROWS { bf16_t* rp = tb + (size_t)(ai * 128 + m * 16) * ld;
#pragma unroll
            for (int bj = 0; bj < 2; ++bj) *(u32x4v*)(rp + bj * 128) = pack8(acc[ai][bj][m][0], acc[ai][bj][m][1]); }
    }
};
struct EpiUp {
    static constexpr bool PERM = true, AFTER_DRAIN = false; bf16_t* O; int ld;
    __device__ __forceinline__ void operator()(const f32x4 (&acc)[2][2][4][2], const pg8::Unit& u, int wr, int wc, int fr, int fq) const {
        bf16_t* tb = O + (size_t)(u.pm * 256 + wr * 64 + fr) * ld + u.pn * 256 + wc * 32 + 8 * fq;
#pragma unroll
        EPI_LOOP_ROWS { bf16_t* rp = tb + (size_t)(ai * 128 + m * 16) * ld;
#pragma unroll
            for (int bj = 0; bj < 2; ++bj) *(u32x4v*)(rp + bj * 128) = pack8(acc[ai][bj][m][0], acc[ai][bj][m][1]); }
    }
};
struct EpiGateA {
    static constexpr bool PERM = true, AFTER_DRAIN = false; const bf16_t* G; float* T;
    __device__ __forceinline__ void operator()(const f32x4 (&acc)[2][2][4][2], const pg8::Unit& u, int wr, int wc, int fr, int fq) const {
        const size_t off0 = (size_t)(u.pm * 256 + wr * 64 + fr) * 1024 + u.pn * 256 + wc * 32 + 8 * fq;
#pragma unroll
        EPI_LOOP_ROWS {
#pragma unroll
            for (int bj = 0; bj < 2; ++bj) { const size_t off = off0 + (size_t)(ai * 128 + m * 16) * 1024 + bj * 128; const u32x4v g = *(const u32x4v*)(G + off);
                f32x4 a = acc[ai][bj][m][0], b = acc[ai][bj][m][1];
                a[0] *= sigm(bflo(g.x)); a[1] *= sigm(bfhi(g.x)); a[2] *= sigm(bflo(g.y)); a[3] *= sigm(bfhi(g.y));
                b[0] *= sigm(bflo(g.z)); b[1] *= sigm(bfhi(g.z)); b[2] *= sigm(bflo(g.w)); b[3] *= sigm(bfhi(g.w));
                *(f32x4*)(T + off) = a; *(f32x4*)(T + off + 4) = b; } }
    }
};
struct EpiGateB {
    static constexpr bool PERM = true, AFTER_DRAIN = false; const bf16_t* G; const float* T; bf16_t* O;
    __device__ __forceinline__ void operator()(const f32x4 (&acc)[2][2][4][2], const pg8::Unit& u, int wr, int wc, int fr, int fq) const {
        const size_t off0 = (size_t)(u.pm * 256 + wr * 64 + fr) * 1024 + u.pn * 256 + wc * 32 + 8 * fq;
#pragma unroll
        EPI_LOOP_ROWS {
#pragma unroll
            for (int bj = 0; bj < 2; ++bj) { const size_t off = off0 + (size_t)(ai * 128 + m * 16) * 1024 + bj * 128; const u32x4v g = *(const u32x4v*)(G + off);
                f32x4 a = acc[ai][bj][m][0], b = acc[ai][bj][m][1]; const f32x4 ta = *(const f32x4*)(T + off), tb = *(const f32x4*)(T + off + 4);
                a[0] = ta[0] + a[0] * sigm(bflo(g.x)); a[1] = ta[1] + a[1] * sigm(bfhi(g.x)); a[2] = ta[2] + a[2] * sigm(bflo(g.y)); a[3] = ta[3] + a[3] * sigm(bfhi(g.y));
                b[0] = tb[0] + b[0] * sigm(bflo(g.z)); b[1] = tb[1] + b[1] * sigm(bfhi(g.z)); b[2] = tb[2] + b[2] * sigm(bflo(g.w)); b[3] = tb[3] + b[3] * sigm(bfhi(g.w));
                *(u32x4v*)(O + off) = pack8(a, b); } }
    }
};
struct EpiStat {
    static constexpr bool PERM = true, AFTER_DRAIN = false; bf16_t* O; float* stat;
    __device__ __forceinline__ void operator()(const f32x4 (&acc)[2][2][4][2], const pg8::Unit& u, int wr, int wc, int fr, int fq) const {
        const int row0 = u.pm * 256 + wr * 64 + fr; const size_t off0 = (size_t)row0 * 1024 + u.pn * 256 + wc * 32 + 8 * fq;
#pragma unroll
        EPI_LOOP_ROWS { float ss = 0.f;
#pragma unroll
            for (int bj = 0; bj < 2; ++bj) { const size_t off = off0 + (size_t)(ai * 128 + m * 16) * 1024 + bj * 128; const f32x4 a = acc[ai][bj][m][0], b = acc[ai][bj][m][1];
                ss += a[0] * a[0] + a[1] * a[1] + a[2] * a[2] + a[3] * a[3] + b[0] * b[0] + b[1] * b[1] + b[2] * b[2] + b[3] * b[3];
                *(u32x4v*)(O + off) = pack8(a, b); }
            ss += __shfl_xor(ss, 16); ss += __shfl_xor(ss, 32);
            if (fq == 0) atomicAdd(stat + row0 + ai * 128 + m * 16, ss); }
    }
};
template <class Epi> __device__ __forceinline__ void run_gemm(LAS unsigned char* lds, const bf16_t* A, const bf16_t* Bt, int M, int N, int K, const Epi& E) {
    pg8::Gemm g; g.A = A; g.Bt = Bt; g.M = M; g.N = N; g.K = K;
    pg8::StaticOrder S; S.init(M, N, (int)gridDim.x, (int)blockIdx.x);
    pg8::gemm_phase<Epi, pg8::StaticOrder, false>(lds, g, S, E, nullptr);
}

template <bool REV> __device__ __forceinline__ void lru_scan(f32x4 (&acc)[8][2], int lane, int fq, float carry_in, float& Ptile, float& Htile, bool want_out) {
    const int lfq = REV ? 3 - fq : fq;
    const int src1 = (REV ? lane + 16 : lane - 16) & 63, src2 = (REV ? lane + 32 : lane - 32) & 63, srcT = REV ? (lane & 15) : (lane & 15) + 48;
    float carry = carry_in, Pacc = 1.f;
#pragma unroll
    for (int mm = 0; mm < 8; ++mm) { const int m = REV ? 7 - mm : mm;
        float P = 1.f, H = 0.f;
#pragma unroll
        for (int ii = 0; ii < 4; ++ii) { const int i = REV ? 3 - ii : ii; const float a = acc[m][0][i], b = acc[m][1][i]; H = a * H + b; P *= a; }
        float Pp = __shfl(P, src1), Hp = __shfl(H, src1); if (lfq >= 1) { H = P * Hp + H; P = P * Pp; }
        Pp = __shfl(P, src2); Hp = __shfl(H, src2); if (lfq >= 2) { H = P * Hp + H; P = P * Pp; }
        float Pe = __shfl(P, src1), He = __shfl(H, src1); if (lfq == 0) { Pe = 1.f; He = 0.f; }
        const float Pt = __shfl(P, srcT), Ht = __shfl(H, srcT);
        if (want_out) { float h = Pe * carry + He;
#pragma unroll
            for (int ii = 0; ii < 4; ++ii) { const int i = REV ? 3 - ii : ii; h = acc[m][0][i] * h + acc[m][1][i]; acc[m][0][i] = h; } }
        carry = Pt * carry + Ht; Pacc *= Pt; }
    Ptile = Pacc; Htile = carry;
}

template <int PASS> __device__ void lru_phase(const Params& p, LAS unsigned char* lds) {
    const int tid = threadIdx.x, lane = tid & 63, w = tid >> 6, fr = lane & 15, fq = lane >> 4;
    const bf16_t* xa = (const bf16_t*)(p.ws + REG(0)); const bf16_t* ya = (const bf16_t*)(p.ws + REG(1)); bf16_t* hy = (bf16_t*)p.out;
    const bf16_t* WgT = (const bf16_t*)(p.ws + OFF_WG);
    float2* agg = (float2*)(p.ws + OFF_AGG); const float* car = (const float*)(p.ws + OFF_CAR);
    LAS unsigned char* raw = lds;
    LAS unsigned char* xc = lds + 33792;
    LAS unsigned char* hs = lds + 68608;
    for (int tile = blockIdx.x; tile < 5120; tile += gridDim.x) {
        const int hd = tile & 7, cidx = tile >> 3, tok0 = cidx * 128;
        int S, s0; if (tok0 < NPR) { S = 4096; s0 = tok0 & 4095; } else { S = 8192; s0 = (tok0 - NPR) & 8191; }
        for (int idx = tid; idx < 131 * 16; idx += 512) { const int r = idx >> 4, v = idx & 15, s = s0 - 2 + r; u32x4v val = {0u, 0u, 0u, 0u};
            if (s >= 0 && s < S) val = *(const u32x4v*)(xa + (size_t)(tok0 - 2 + r) * 1024 + hd * 128 + v * 8);
            *(LAS u32x4v*)(raw + r * 256 + v * 16) = val; }
        __syncthreads();
        { const int v = tid & 15; float cw[4][8], cb[8];
#pragma unroll
            for (int e = 0; e < 8; ++e) { cb[e] = p.conv_b[hd * 128 + v * 8 + e];
#pragma unroll
                for (int k = 0; k < 4; ++k) cw[k][e] = p.conv_w[k * 1024 + hd * 128 + v * 8 + e]; }
#pragma unroll
            for (int it = 0; it < 4; ++it) { const int t = (tid >> 4) + it * 32; float o[8];
#pragma unroll
                for (int e = 0; e < 8; ++e) o[e] = cb[e];
#pragma unroll
                for (int k = 0; k < 4; ++k) { const u32x4v rv = *(LAS u32x4v*)(raw + (t + k) * 256 + v * 16);
                    o[0] += cw[k][0] * bflo(rv.x); o[1] += cw[k][1] * bfhi(rv.x); o[2] += cw[k][2] * bflo(rv.y); o[3] += cw[k][3] * bfhi(rv.y);
                    o[4] += cw[k][4] * bflo(rv.z); o[5] += cw[k][5] * bfhi(rv.z); o[6] += cw[k][6] * bflo(rv.w); o[7] += cw[k][7] * bfhi(rv.w); }
                u32x4v ov; ov.x = cvt_pk_bf16(o[0], o[1]); ov.y = cvt_pk_bf16(o[2], o[3]); ov.z = cvt_pk_bf16(o[4], o[5]); ov.w = cvt_pk_bf16(o[6], o[7]);
                *(LAS u32x4v*)(xc + t * 272 + v * 16) = ov; } }
        __syncthreads();
        const int chl = w * 16 + fr, ch = hd * 128 + chl;
        f32x4 hsum[8];
#pragma unroll
        for (int dir = 0; dir < 2; ++dir) {
            bf16x8 Bf[2][4];
#pragma unroll
            for (int g = 0; g < 2; ++g)
#pragma unroll
                for (int ks = 0; ks < 4; ++ks) Bf[g][ks] = *(const bf16x8*)(WgT + (size_t)(hd * 512 + (dir * 2 + g) * 128 + chl) * 128 + ks * 32 + fq * 8);
            f32x4 acc[8][2];
#pragma unroll
            for (int m = 0; m < 8; ++m) { acc[m][0] = (f32x4){0.f, 0.f, 0.f, 0.f}; acc[m][1] = (f32x4){0.f, 0.f, 0.f, 0.f}; }
#pragma unroll
            for (int m = 0; m < 8; ++m)
#pragma unroll
                for (int ks = 0; ks < 4; ++ks) { const bf16x8 a = *(LAS bf16x8*)(xc + (m * 16 + fr) * 272 + (ks * 32 + fq * 8) * 2);
                    acc[m][0] = __builtin_amdgcn_mfma_f32_16x16x32_bf16(a, Bf[0][ks], acc[m][0], 0, 0, 0);
                    acc[m][1] = __builtin_amdgcn_mfma_f32_16x16x32_bf16(a, Bf[1][ks], acc[m][1], 0, 0, 0);
                    if (ks == 3) __builtin_amdgcn_sched_barrier(0); }
            const float ba = p.b_lru_a[dir * 1024 + ch], bx = p.b_lru_x[dir * 1024 + ch];
            const float c8sp = 8.0f * log1pf(__expf(-p.lru_lambda[dir * 1024 + ch]));
#pragma unroll
            for (int m = 0; m < 8; ++m)
#pragma unroll
                for (int i = 0; i < 4; ++i) { const float r = sigm(acc[m][0][i] + ba), ig = sigm(acc[m][1][i] + bx);
                    const float a = __expf(-c8sp * r); const float mult = sqrtf(fmaxf(1.0f - a * a, 0.0f));
                    const float xv = bf2f((unsigned)*(LAS bf16_t*)(xc + (m * 16 + 4 * fq + i) * 272 + chl * 2));
                    acc[m][0][i] = a; acc[m][1][i] = mult * ig * xv; if (i == 3) __builtin_amdgcn_sched_barrier(0); }
            float Pt, Ht;
            const float cin = PASS == 0 ? 0.f : car[(size_t)(cidx * 2 + dir) * 1024 + ch];
            if (dir == 0) lru_scan<false>(acc, lane, fq, cin, Pt, Ht, PASS == 1); else lru_scan<true>(acc, lane, fq, cin, Pt, Ht, PASS == 1);
            if (PASS == 0) { if (fq == 0) agg[(size_t)(cidx * 2 + dir) * 1024 + ch] = make_float2(Pt, Ht); }
            else {
#pragma unroll
                for (int m = 0; m < 8; ++m) hsum[m] = dir == 0 ? acc[m][0] : hsum[m] + acc[m][0]; }
        }
        if (PASS == 1) {
#pragma unroll
            for (int m = 0; m < 8; ++m)
#pragma unroll
                for (int i = 0; i < 4; ++i) *(LAS bf16_t*)(hs + (m * 16 + 4 * fq + i) * 256 + chl * 2) = f2bf(hsum[m][i]);
            __syncthreads();
#pragma unroll
            for (int it = 0; it < 4; ++it) { const int idx = tid + it * 512, t = idx >> 4, v = idx & 15; const size_t go = (size_t)(tok0 + t) * 1024 + hd * 128 + v * 8;
                const u32x4v hv = *(LAS u32x4v*)(hs + t * 256 + v * 16); const u32x4v yv = *(const u32x4v*)(ya + go); u32x4v o;
                o.x = cvt_pk_bf16(bflo(hv.x) * gelu_t(bflo(yv.x)), bfhi(hv.x) * gelu_t(bfhi(yv.x))); o.y = cvt_pk_bf16(bflo(hv.y) * gelu_t(bflo(yv.y)), bfhi(hv.y) * gelu_t(bfhi(yv.y)));
                o.z = cvt_pk_bf16(bflo(hv.z) * gelu_t(bflo(yv.z)), bfhi(hv.z) * gelu_t(bfhi(yv.z))); o.w = cvt_pk_bf16(bflo(hv.w) * gelu_t(bflo(yv.w)), bfhi(hv.w) * gelu_t(bfhi(yv.w)));
                *(u32x4v*)(hy + go) = o; }
        }
    }
    __syncthreads();
}
__device__ void carry_phase(const Params& p) {
    const float2* agg = (const float2*)(p.ws + OFF_AGG); float* car = (float*)(p.ws + OFF_CAR);
    for (int i = blockIdx.x * 512 + threadIdx.x; i < 18 * 2 * 1024; i += gridDim.x * 512) {
        const int ch = i & 1023, dir = (i >> 10) & 1, seq = i >> 11;
        const int c0 = seq < 16 ? seq * 32 : 512 + (seq - 16) * 64, nc = seq < 16 ? 32 : 64;
        float c = 0.f;
        for (int j = 0; j < nc; ++j) { const int ci = c0 + (dir == 0 ? j : nc - 1 - j); const size_t o = (size_t)(ci * 2 + dir) * 1024 + ch; const float2 a = agg[o]; car[o] = c; c = a.x * c + a.y; }
    }
}

__device__ __forceinline__ u32x2v tr_read(unsigned addr) { u32x2v r; asm volatile("ds_read_b64_tr_b16 %0, %1\n\ts_waitcnt lgkmcnt(0)" : "=&v"(r) : "v"(addr) : "memory"); return r; }

template <int MT, int K, int STEP>
__device__ __forceinline__ void dft_tile(const Params& p, LAS unsigned char* Al, LAS unsigned char* Dl, int seqtok, int S, int N2, int n0, int k1) {
    const int tid = threadIdx.x, lane = tid & 63, w = tid >> 6, fr = lane & 15, fq = lane >> 4;
    constexpr int KS = K / 32, MB = MT / 16, AST = 2 * K + 16;
    const bf16_t* src0 = STEP == 1 ? (const bf16_t*)(p.ws + REG(4)) + (size_t)seqtok * 1024 + n0
                                   : (const bf16_t*)(p.ws + REG(5)) + (size_t)seqtok * 1024 + (size_t)(2 * k1) * N2 * 512 + n0;
#pragma unroll
    for (int it = 0; it < K * 16 / 512; ++it) { const int idx = tid + it * 512, kk = idx >> 4, v = idx & 15;
        size_t ro;
        if (STEP == 1) { const int part = kk >> 6, s1 = kk & 63; ro = (size_t)part * S * 512 + (size_t)(s1 * N2) * 512; }
        else { const int part = kk / (K / 2), s2 = kk % (K / 2); ro = (size_t)part * N2 * 512 + (size_t)s2 * 512; }
        *(LAS u32x4v*)(Dl + kk * 288 + v * 16) = *(const u32x4v*)(src0 + ro + v * 8); }
    __syncthreads();
    bf16x8 Bf[KS];
    { const int q = fr >> 2, pp = fr & 3; const unsigned base = (unsigned)(size_t)Dl + (unsigned)((4 * fq + q) * 288 + (16 * w + 4 * pp) * 2);
#pragma unroll
        for (int ks = 0; ks < KS; ++ks) { const u32x2v r0 = tr_read(base + (unsigned)((32 * ks) * 288)), r1 = tr_read(base + (unsigned)((32 * ks + 16) * 288));
            u32x4v t; t.x = r0.x; t.y = r0.y; t.z = r1.x; t.w = r1.y; Bf[ks] = __builtin_bit_cast(bf16x8, t); } }
    f32x4 acc[MB];
#pragma unroll
    for (int mb = 0; mb < MB; ++mb) { acc[mb] = (f32x4){0.f, 0.f, 0.f, 0.f};
#pragma unroll
        for (int ks = 0; ks < KS; ++ks) { const bf16x8 a = *(LAS bf16x8*)(Al + (16 * mb + fr) * AST + (32 * ks + 8 * fq) * 2);
            acc[mb] = __builtin_amdgcn_mfma_f32_16x16x32_bf16(a, Bf[ks], acc[mb], 0, 0, 0); } }
    const int n = n0 + 16 * w + fr;
    if (STEP == 1) {
        const float2* tw = (const float2*)(p.ws + (S == 4096 ? OFF_TW4 : OFF_TW8)); const int s2 = n >> 9;
        bf16_t* o = (bf16_t*)(p.ws + REG(5)) + (size_t)seqtok * 1024 + n; const size_t rstr = (size_t)N2 * 512;
#pragma unroll
        for (int mb = 0; mb < MB; ++mb)
#pragma unroll
            for (int ii = 0; ii < 2; ++ii) { const int kk1 = 8 * mb + 2 * fq + ii; const float2 cs = tw[kk1 * s2]; const float re = acc[mb][2 * ii], im = acc[mb][2 * ii + 1];
                o[(size_t)(2 * kk1) * rstr] = f2bf(re * cs.x + im * cs.y); o[(size_t)(2 * kk1 + 1) * rstr] = f2bf(im * cs.x - re * cs.y); }
    } else {
        bf16_t* o = (bf16_t*)(p.ws + REG(4)) + (size_t)(seqtok + k1) * 512 + n; const float scale = rsqrtf((float)S * 128.0f);
#pragma unroll
        for (int mb = 0; mb < MB; ++mb)
#pragma unroll
            for (int i = 0; i < 4; ++i) { const int k2 = 16 * mb + 4 * fq + i; o[(size_t)(64 * k2) * 512] = f2bf(acc[mb][i] * scale); }
    }
    __syncthreads();
}
__device__ __forceinline__ void dft_loadA(LAS unsigned char* Al, const bf16_t* Ag, int MT, int K) {
    const int vpr = K / 8, total = MT * vpr;
    for (int idx = threadIdx.x; idx < total; idx += 512) { const int r = idx / vpr, v = idx % vpr; *(LAS u32x4v*)(Al + r * (2 * K + 16) + v * 16) = *(const u32x4v*)(Ag + (size_t)r * K + v * 8); }
}
__device__ void dft_phase(const Params& p, LAS unsigned char* lds, int step) {
    LAS unsigned char* Al = lds; LAS unsigned char* Dl = lds + 67584;
    int curA = -1;
    if (step == 1) {
        dft_loadA(Al, (const bf16_t*)(p.ws + OFF_DA1), 128, 128);
        for (int tile = blockIdx.x; tile < 5120; tile += gridDim.x) {
            int seq, ti, S, N2; if (tile < 1024) { seq = 16 + (tile >> 9); ti = tile & 511; S = 8192; N2 = 128; } else { const int t2 = tile - 1024; seq = t2 >> 8; ti = t2 & 255; S = 4096; N2 = 64; }
            const int seqtok = seq < 16 ? seq * 4096 : NPR + (seq - 16) * 8192;
            dft_tile<128, 128, 1>(p, Al, Dl, seqtok, S, N2, ti * 128, 0);
        }
    } else {
        for (int tile = blockIdx.x; tile < 4608; tile += gridDim.x) {
            if (tile < 512) { const int seq = 16 + (tile >> 8), r = tile & 255, k1 = r >> 2, n0 = (r & 3) * 128;
                if (curA != 2) { __syncthreads(); dft_loadA(Al, (const bf16_t*)(p.ws + OFF_DA3L), 128, 256); curA = 2; }
                dft_tile<128, 256, 3>(p, Al, Dl, NPR + (seq - 16) * 8192, 8192, 128, n0, k1);
            } else { const int t2 = tile - 512, seq = t2 >> 8, r = t2 & 255, k1 = r >> 2, n0 = (r & 3) * 128;
                if (curA != 1) { __syncthreads(); dft_loadA(Al, (const bf16_t*)(p.ws + OFF_DA3S), 64, 128); curA = 1; }
                dft_tile<64, 128, 3>(p, Al, Dl, seq * 4096, 4096, 64, n0, k1);
            }
        }
    }
    __syncthreads();
}

__device__ void convgelu_phase(const Params& p, int tile0, int ntile) {
    const int PC = ntile * 256; const bf16_t* up = (const bf16_t*)(p.ws + REG(1)); bf16_t* gout = (bf16_t*)(p.ws + REG(3));
    const int total = (NTOK / 32) * ntile * 16;
    for (int idx = blockIdx.x * 512 + threadIdx.x; idx < total; idx += gridDim.x * 512) {
        const int v = idx & 15, q = idx >> 4, nl = q % ntile, run = q / ntile, j0 = 128 * (tile0 + nl) + 8 * v, t0 = run * 32;
        int S, s0; if (t0 < NPR) { S = 4096; s0 = t0 & 4095; } else { S = 8192; s0 = (t0 - NPR) & 8191; }
        float wv[3][8], wg[3][8], bv[8], bg[8];
#pragma unroll
        for (int e = 0; e < 8; ++e) { bv[e] = p.ffn_conv_b[j0 + e]; bg[e] = p.ffn_conv_b[2816 + j0 + e];
#pragma unroll
            for (int k = 0; k < 3; ++k) { wv[k][e] = p.ffn_conv_w[k * 5632 + j0 + e]; wg[k][e] = p.ffn_conv_w[k * 5632 + 2816 + j0 + e]; } }
        const bf16_t* base = up + (size_t)t0 * PC + nl * 256 + 8 * v;
        u32x4v av = {0u, 0u, 0u, 0u}, ag = {0u, 0u, 0u, 0u};
        if (s0 > 0) { av = *(const u32x4v*)(base - PC); ag = *(const u32x4v*)(base - PC + 128); }
        u32x4v bvv = *(const u32x4v*)(base), bgg = *(const u32x4v*)(base + 128);
#pragma unroll 2
        for (int tt = 0; tt < 32; ++tt) {
            u32x4v cv = {0u, 0u, 0u, 0u}, cg = {0u, 0u, 0u, 0u};
            if (s0 + tt + 1 < S) { cv = *(const u32x4v*)(base + (size_t)(tt + 1) * PC); cg = *(const u32x4v*)(base + (size_t)(tt + 1) * PC + 128); }
            float ov[8], og[8];
#define CG_E(e, A, B, C, FN) (wv[0][e] * FN(A) + wv[1][e] * FN(B) + wv[2][e] * FN(C))
#define CG_G(e, A, B, C, FN) (wg[0][e] * FN(A) + wg[1][e] * FN(B) + wg[2][e] * FN(C))
            ov[0] = bv[0] + CG_E(0, av.x, bvv.x, cv.x, bflo); ov[1] = bv[1] + CG_E(1, av.x, bvv.x, cv.x, bfhi); ov[2] = bv[2] + CG_E(2, av.y, bvv.y, cv.y, bflo); ov[3] = bv[3] + CG_E(3, av.y, bvv.y, cv.y, bfhi);
            ov[4] = bv[4] + CG_E(4, av.z, bvv.z, cv.z, bflo); ov[5] = bv[5] + CG_E(5, av.z, bvv.z, cv.z, bfhi); ov[6] = bv[6] + CG_E(6, av.w, bvv.w, cv.w, bflo); ov[7] = bv[7] + CG_E(7, av.w, bvv.w, cv.w, bfhi);
            og[0] = bg[0] + CG_G(0, ag.x, bgg.x, cg.x, bflo); og[1] = bg[1] + CG_G(1, ag.x, bgg.x, cg.x, bfhi); og[2] = bg[2] + CG_G(2, ag.y, bgg.y, cg.y, bflo); og[3] = bg[3] + CG_G(3, ag.y, bgg.y, cg.y, bfhi);
            og[4] = bg[4] + CG_G(4, ag.z, bgg.z, cg.z, bflo); og[5] = bg[5] + CG_G(5, ag.z, bgg.z, cg.z, bfhi); og[6] = bg[6] + CG_G(6, ag.w, bgg.w, cg.w, bflo); og[7] = bg[7] + CG_G(7, ag.w, bgg.w, cg.w, bfhi);
            u32x4v o; o.x = cvt_pk_bf16(gelu_t(og[0]) * ov[0], gelu_t(og[1]) * ov[1]); o.y = cvt_pk_bf16(gelu_t(og[2]) * ov[2], gelu_t(og[3]) * ov[3]);
            o.z = cvt_pk_bf16(gelu_t(og[4]) * ov[4], gelu_t(og[5]) * ov[5]); o.w = cvt_pk_bf16(gelu_t(og[6]) * ov[6], gelu_t(og[7]) * ov[7]);
            *(u32x4v*)(gout + (size_t)(t0 + tt) * 2816 + j0) = o;
            av = bvv; ag = bgg; bvv = cv; bgg = cg;
        }
    }
}

constexpr int N_PHASES = 18;
#ifndef PH_MASK
#define PH_MASK 0xFFFFFFFFu
#endif
#define EN(n) ((PH_MASK >> (n)) & 1u)
#ifndef ONE_LAUNCH
#define ONE_LAUNCH 0
#endif
template <int PH> __device__ __forceinline__ void run_phase(const Params& p, LAS unsigned char* lds) {
    unsigned char* ws = p.ws;
    if constexpr (PH == 0) { if (EN(0)) prep_phase(p, lds); }
    else if constexpr (PH == 1) { if (EN(1)) h1_phase(p); }
    else if constexpr (PH == 2) { if (EN(2)) { EpiIn E; E.ws = ws; run_gemm(lds, (const bf16_t*)p.out, (const bf16_t*)(ws + OFF_WIN), NTOK, 5120, 1024, E); } }
    else if constexpr (PH == 3) { if (EN(3)) lru_phase<0>(p, lds); if (EN(18)) dft_phase(p, lds, 1); }
    else if constexpr (PH == 4) { if (EN(4)) carry_phase(p); if (EN(19)) dft_phase(p, lds, 3); }
    else if constexpr (PH == 5) { if (EN(5)) lru_phase<1>(p, lds); }
    else if constexpr (PH == 6) { if (EN(6)) { EpiGateA E; E.G = (const bf16_t*)(ws + REG(2)); E.T = (float*)(ws + REG(0)); run_gemm(lds, (const bf16_t*)p.out, (const bf16_t*)(ws + OFF_WA), NTOK, 1024, 1024, E); } }
    else if constexpr (PH == 7) { if (EN(7)) { EpiGateB E; E.G = (const bf16_t*)(ws + REG(3)); E.T = (const float*)(ws + REG(0)); E.O = (bf16_t*)(ws + REG(5)); run_gemm(lds, (const bf16_t*)(ws + REG(4)), (const bf16_t*)(ws + OFF_WB), NTOK, 1024, 512, E); } }
    else if constexpr (PH == 8) { if (EN(8)) { EpiStat E; E.O = (bf16_t*)(ws + REG(2)); E.stat = (float*)(ws + OFF_ST1); run_gemm(lds, (const bf16_t*)(ws + REG(5)), (const bf16_t*)(ws + OFF_WO), NTOK, 1024, 1024, E); } }
    else if constexpr (PH == 9) { if (EN(9)) x1_phase(p); }
    else if constexpr (PH == 10 || PH == 12 || PH == 14) { if (EN(10)) { constexpr int part = (PH - 10) >> 1, tile0 = part * 8, ntile = part < 2 ? 8 : 6;
        EpiUp E; E.O = (bf16_t*)(ws + REG(1)); E.ld = ntile * 256; run_gemm(lds, (const bf16_t*)(ws + REG(0)), (const bf16_t*)(ws + OFF_WUP) + (size_t)tile0 * 256 * 1024, NTOK, ntile * 256, 1024, E); } }
    else if constexpr (PH == 11 || PH == 13 || PH == 15) { if (EN(11)) { constexpr int part = (PH - 11) >> 1; convgelu_phase(p, part * 8, part < 2 ? 8 : 6); } }
    else if constexpr (PH == 16) { if (EN(16)) { EpiStat E; E.O = (bf16_t*)(ws + REG(1)); E.stat = (float*)(ws + OFF_ST2); run_gemm(lds, (const bf16_t*)(ws + REG(3)), (const bf16_t*)(ws + OFF_WD), NTOK, 1024, 2816, E); } }
    else if constexpr (PH == 17) { if (EN(17)) final_phase(p); }
}
__global__ void __launch_bounds__(512, 2) mega_kernel(Params p) {
    extern __shared__ __attribute__((aligned(16))) unsigned char shm[];
    LAS unsigned char* lds = (LAS unsigned char*)shm;
#if ONE_LAUNCH
    cg::grid_group grid = cg::this_grid();
#define PHS(n) run_phase<n>(p, lds); grid.sync();
    PHS(0) PHS(1) PHS(2) PHS(3) PHS(4) PHS(5) PHS(6) PHS(7) PHS(8) PHS(9) PHS(10) PHS(11) PHS(12) PHS(13) PHS(14) PHS(15) PHS(16)
    run_phase<17>(p, lds);
#else
#define PHC(n) case n: run_phase<n>(p, lds); break;
    switch (p.ph_lo) { PHC(0) PHC(1) PHC(2) PHC(3) PHC(4) PHC(5) PHC(6) PHC(7) PHC(8) PHC(9) PHC(10) PHC(11) PHC(12) PHC(13) PHC(14) PHC(15) PHC(16) PHC(17) }
#endif
}

extern "C" void kernel_launch(void* const* d_in, const int* in_sizes, int n_in, void* d_out, int out_size, void* d_ws, size_t ws_size, hipStream_t stream) {
    static int grid = 0;
    if (grid == 0) {
        if (ws_size < OFF_BIG + 6 * REG_BYTES) { fprintf(stderr, "kernel_launch: workspace too small (%zu)\n", ws_size); grid = -1; return; }
        int dev = 0, cus = 0, per_cu = 0;
        hipGetDevice(&dev); hipDeviceGetAttribute(&cus, hipDeviceAttributeMultiprocessorCount, dev);
        if (hipFuncSetAttribute((const void*)mega_kernel, hipFuncAttributeMaxDynamicSharedMemorySize, LDS_BYTES) != hipSuccess) { fprintf(stderr, "kernel_launch: hipFuncSetAttribute failed\n"); grid = -1; return; }
        if (hipOccupancyMaxActiveBlocksPerMultiprocessor(&per_cu, (const void*)mega_kernel, 512, LDS_BYTES) != hipSuccess || per_cu < 1) { fprintf(stderr, "kernel_launch: occupancy query gave %d\n", per_cu); per_cu = 1; }
        (void)hipGetLastError();
        grid = cus * per_cu;
    }
    if (grid < 0) return;
    Params p{};
    const float** pp = (const float**)&p;
    for (int i = 0; i < 25; ++i) pp[i] = (const float*)d_in[i];
    p.out = (float*)d_out; p.ws = (unsigned char*)d_ws;
#if ONE_LAUNCH
    p.ph_lo = 0; p.ph_hi = N_PHASES;
    void* args[] = {&p};
    hipError_t e = hipLaunchCooperativeKernel((const void*)mega_kernel, dim3(grid), dim3(512), args, LDS_BYTES, stream);
    if (e != hipSuccess) fprintf(stderr, "cooperative launch failed: %s (grid %d)\n", hipGetErrorString(e), grid);
#else
    for (int ph = 0; ph < N_PHASES; ++ph) { p.ph_lo = ph; p.ph_hi = ph + 1; hipLaunchKernelGGL(mega_kernel, dim3(grid), dim3(512), LDS_BYTES, stream, p); }
#endif
}
```

```cpp
#include <hip/hip_runtime.h>
#include <hip/hip_cooperative_groups.h>
#include <cstdio>
namespace cg = cooperative_groups;

namespace pg8 {
#define PG8_LAS __attribute__((address_space(3)))
typedef unsigned short bf16_t;
typedef short bf16x8 __attribute__((ext_vector_type(8)));
typedef float f32x4 __attribute__((ext_vector_type(4)));
typedef unsigned u32x4 __attribute__((ext_vector_type(4)));
constexpr int BM = 256, BK = 64, HALF = 128, HTB = HALF * BK * 2  , STAGE_BYTES = 8 * HTB, NXCD = 8, WGM = 8;

__host__ __device__ __forceinline__ int lds_byte(int r, int c) { const int st = (r >> 4) * 2 + (c >> 5), rr = r & 15, cc = c & 31, ob = rr * 64 + cc * 2; return st * 1024 + (ob ^ (((ob >> 9) & 1) << 5)); }
__host__ __device__ __forceinline__ void stage_rc(int b, int& R, int& C) { const int st = b / 1024, sb = b % 1024, swz = sb ^ (((sb >> 9) & 1) << 5); R = (st >> 1) * 16 + swz / 64; C = (st & 1) * 32 + (swz % 64) / 2; }
__host__ __device__ __forceinline__ int perm32(int rho) { const int n = rho >> 4, i = rho & 15; return 8 * (i >> 2) + 4 * n + (i & 3); }

struct Unit { int pm, pn; };
struct Gemm { const bf16_t* A; const bf16_t* Bt; int M, N, K; };

struct StaticOrder {
    int nM, nN, nwg, G, c;
    __host__ __device__ void init(int M, int N, int G_, int c_) { nM = M / BM; nN = N / BM; nwg = nM * nN; G = G_; c = c_; }
    __host__ __device__ bool next(int i, Unit& u) const {
        const long L = (long)i * G + c; if (L >= nwg) return false;
        int wgid = (int)L; { const int q = nwg / NXCD, r = nwg % NXCD, xcd = wgid % NXCD, off = wgid / NXCD; wgid = (xcd < r ? xcd * (q + 1) : r * (q + 1) + (xcd - r) * q) + off; }
        const int nig = WGM * nN, gid = wgid / nig, fm = gid * WGM, gsz = (nM - fm) < WGM ? (nM - fm) : WGM;
        u.pm = fm + ((wgid % nig) % gsz); u.pn = (wgid % nig) / gsz; return true;
    }
    __device__ __forceinline__ void a_ready(const Unit&) const {}
    __device__ __forceinline__ void done(const Unit&) const {}
};
__device__ __forceinline__ unsigned cvt_pk_bf16(float lo, float hi) { unsigned r; asm volatile("v_cvt_pk_bf16_f32 %0, %1, %2" : "=v"(r) : "v"(lo), "v"(hi)); return r; }
typedef float f32x2 __attribute__((ext_vector_type(2)));
template <class Epi, class Sched, bool STAMP = false>
__device__ __forceinline__ void gemm_phase(PG8_LAS unsigned char* lds, const Gemm g, const Sched& S, const Epi& E, unsigned long long* stamps) {
    int tid_ = threadIdx.x; asm volatile("" : "+v"(tid_));
    const int tid = tid_, wid = __builtin_amdgcn_readfirstlane(tid >> 6), lane = tid & 63, wr = wid >> 2, wc = wid & 3, fr = lane & 15, fq = lane >> 4;
    const int K = g.K, nt = K / BK;
    int ts_lo = 0, ts_hi = 0, nts = 0; const unsigned long long rt_entry = STAMP ? (unsigned long long)wall_clock64() : 0ull;
#define PG8_STAMP() do { if (STAMP && wid == 0 && nts < 64) { const unsigned long long _c = (unsigned long long)clock64(); \
        ts_lo = (lane == nts) ? (int)(unsigned)_c : ts_lo; ts_hi = (lane == nts) ? (int)(unsigned)(_c >> 32) : ts_hi; ++nts; } } while (0)
    PG8_STAMP();
    unsigned voffA[2], voffB[2];
#pragma unroll
    for (int i = 0; i < 2; ++i) { int R, C; stage_rc(tid * 16 + i * 8192, R, C); const int Rb = Epi::PERM ? ((R & ~31) + perm32(R & 31)) : R;
        voffA[i] = (unsigned)(R * K + C) * 2u; voffB[i] = (unsigned)(Rb * K + C) * 2u; }
    const size_t kstep = (size_t)(BK * 2);
    const size_t hstep = (size_t)HALF * K * 2;
    const size_t tstep = 2 * hstep;
    const unsigned ldsw = (unsigned)wid * 1024u;
    const int aoff = lds_byte(wr * 64 + fr, fq * 8), boff = lds_byte(wc * 32 + fr, fq * 8);
#define PG8_SA(b, h) (((b) * 2 + (h)) * HTB)
#define PG8_SB(b, h) ((4 + (b) * 2 + (h)) * HTB)
#define PG8_STAGE(bufoff, gbase, voff) do { _Pragma("unroll") for (int _i = 0; _i < 2; ++_i) \
        __builtin_amdgcn_global_load_lds((const unsigned*)((const char*)(gbase) + (voff)[_i]), (PG8_LAS unsigned*)(lds + (bufoff) + ldsw + _i * 8192), 16, 0, 0); } while (0)
#define PG8_LDA(dst, b, h) do { _Pragma("unroll") for (int m = 0; m < 4; ++m) _Pragma("unroll") for (int k = 0; k < 2; ++k) dst[m][k] = *(const PG8_LAS bf16x8*)(lds + PG8_SA(b, h) + aoff + m * 2048 + k * 1024); } while (0)
#define PG8_LDB(dst, b, h) do { _Pragma("unroll") for (int n = 0; n < 2; ++n) _Pragma("unroll") for (int k = 0; k < 2; ++k) dst[n][k] = *(const PG8_LAS bf16x8*)(lds + PG8_SB(b, h) + boff + n * 2048 + k * 1024); } while (0)
#define PG8_MMA(ai, bj, At, Bt) do { __builtin_amdgcn_s_setprio(1); _Pragma("unroll") for (int m = 0; m < 4; ++m) _Pragma("unroll") for (int n = 0; n < 2; ++n) _Pragma("unroll") for (int k = 0; k < 2; ++k) \
        acc[ai][bj][m][n] = __builtin_amdgcn_mfma_f32_16x16x32_bf16(Bt[n][k], At[m][k], acc[ai][bj][m][n], 0, 0, 0); __builtin_amdgcn_s_setprio(0); } while (0)
#define PG8_WAIT_V(n) asm volatile("s_waitcnt vmcnt(" #n ")" ::: "memory")
#define PG8_WAIT_L(n) asm volatile("s_waitcnt lgkmcnt(" #n ")" ::: "memory")
#define PG8_BAR __builtin_amdgcn_s_barrier()
#define PG8_SCHED __builtin_amdgcn_sched_barrier(0)
    Unit cur, nxt; int ui = 0;
    if (!S.next(0, cur)) return;
    f32x4 acc[2][2][4][2];
#pragma unroll
    for (int a = 0; a < 2; ++a)
#pragma unroll
        for (int b = 0; b < 2; ++b)
#pragma unroll
            for (int m = 0; m < 4; ++m)
#pragma unroll
                for (int n = 0; n < 2; ++n) acc[a][b][m][n] = (f32x4){0.f, 0.f, 0.f, 0.f};
    bf16x8 At[4][2], B0[2][2], B1[2][2];
    const char* cA = (const char*)g.A + (size_t)cur.pm * tstep; const char* cB = (const char*)g.Bt + (size_t)cur.pn * tstep;
    S.a_ready(cur);
    PG8_STAGE(PG8_SB(0, 0), cB, voffB); PG8_STAGE(PG8_SA(0, 0), cA, voffA); PG8_STAGE(PG8_SB(0, 1), cB + hstep, voffB); PG8_STAGE(PG8_SA(0, 1), cA + hstep, voffA);
    if (wr == 1) PG8_BAR;
    PG8_WAIT_V(4); PG8_BAR;
    PG8_STAGE(PG8_SB(1, 0), cB + kstep, voffB); PG8_STAGE(PG8_SA(1, 0), cA + kstep, voffA); PG8_STAGE(PG8_SB(1, 1), cB + hstep + kstep, voffB);
    PG8_WAIT_V(6); PG8_BAR;
    PG8_STAMP();
    for (;;) {
        const bool has_next = S.next(ui + 1, nxt);
        const char* nA = has_next ? (const char*)g.A + (size_t)nxt.pm * tstep : cA; const char* nB = has_next ? (const char*)g.Bt + (size_t)nxt.pn * tstep : cB;
        for (int t = 0; t < nt; t += 2) {
            const bool last = (t == nt - 2);
            const char* a1 = cA + (size_t)(t + 1) * kstep;
            const char* a2 = last ? nA : cA + (size_t)(t + 2) * kstep; const char* b2 = last ? nB : cB + (size_t)(t + 2) * kstep;
            const char* a3 = a2 + kstep; const char* b3 = b2 + kstep;
            if (last && has_next) S.a_ready(nxt);
            PG8_LDB(B0, 0, 0); PG8_SCHED; PG8_LDA(At, 0, 0); PG8_STAGE(PG8_SA(1, 1), a1 + hstep, voffA);
            PG8_WAIT_L(8); PG8_BAR; PG8_WAIT_L(0); PG8_MMA(0, 0, At, B0); PG8_BAR; PG8_SCHED;
            PG8_LDB(B1, 0, 1); PG8_STAGE(PG8_SB(0, 0), b2, voffB);
            PG8_BAR; PG8_WAIT_L(0); PG8_MMA(0, 1, At, B1); PG8_BAR;
            PG8_LDA(At, 0, 1); PG8_STAGE(PG8_SA(0, 0), a2, voffA);
            PG8_BAR; PG8_WAIT_L(0); PG8_MMA(1, 0, At, B0); PG8_BAR; PG8_SCHED;
            PG8_STAGE(PG8_SB(0, 1), b2 + hstep, voffB);
            PG8_WAIT_V(6); PG8_BAR; PG8_MMA(1, 1, At, B1); PG8_BAR;
            PG8_LDB(B0, 1, 0); PG8_SCHED; PG8_LDA(At, 1, 0); PG8_STAGE(PG8_SA(0, 1), a2 + hstep, voffA);
            PG8_WAIT_L(8); PG8_BAR; PG8_WAIT_L(0); PG8_MMA(0, 0, At, B0); PG8_BAR; PG8_SCHED;
            PG8_LDB(B1, 1, 1); PG8_STAGE(PG8_SB(1, 0), b3, voffB);
            PG8_BAR; PG8_WAIT_L(0); PG8_MMA(0, 1, At, B1); PG8_BAR;
            PG8_LDA(At, 1, 1); PG8_STAGE(PG8_SA(1, 0), a3, voffA);
            PG8_BAR; PG8_WAIT_L(0); PG8_MMA(1, 0, At, B0); PG8_BAR; PG8_SCHED;
            PG8_STAGE(PG8_SB(1, 1), b3 + hstep, voffB);
            PG8_WAIT_V(6); PG8_BAR; PG8_MMA(1, 1, At, B1); PG8_BAR;
        }
        PG8_STAMP();
        if constexpr (!Epi::AFTER_DRAIN) { E(acc, cur, wr, wc, fr, fq); S.done(cur); }
        PG8_STAMP();
        if (!has_next) break;
#pragma unroll
        for (int a = 0; a < 2; ++a)
#pragma unroll
            for (int b = 0; b < 2; ++b)
#pragma unroll
                for (int m = 0; m < 4; ++m)
#pragma unroll
                    for (int n = 0; n < 2; ++n) acc[a][b][m][n] = (f32x4){0.f, 0.f, 0.f, 0.f};
        cur = nxt; cA = nA; cB = nB; ++ui;
    }
    PG8_WAIT_V(0);
    if (wr == 0) PG8_BAR;
    PG8_BAR;
    if constexpr (Epi::AFTER_DRAIN) { E.fused(acc, cur, wr, wc, fr, fq, lds, wid, lane); S.done(cur); }
    PG8_STAMP();
    if (STAMP && wid == 0) { stamps[lane] = lane < nts ? (((unsigned long long)(unsigned)ts_hi << 32) | (unsigned)ts_lo) : 0ull;
        if (lane == 62) stamps[62] = rt_entry; if (lane == 63) stamps[63] = (unsigned long long)wall_clock64(); }
#undef PG8_STAMP
#undef PG8_SA
#undef PG8_SB
#undef PG8_STAGE
#undef PG8_LDA
#undef PG8_LDB
#undef PG8_MMA
#undef PG8_WAIT_V
#undef PG8_WAIT_L
#undef PG8_BAR
#undef PG8_SCHED
}
}
using pg8::bf16_t; using pg8::bf16x8; using pg8::f32x4; using pg8::cvt_pk_bf16;
#define LAS __attribute__((address_space(3)))
typedef unsigned u32x2v __attribute__((ext_vector_type(2)));
typedef unsigned u32x4v __attribute__((ext_vector_type(4)));

constexpr int NTOK = 81920, NPR = 65536;
constexpr int LDS_BYTES = 147456;
constexpr float RMS_EPS = 1e-6f;

constexpr size_t OFF_WIN = 0, OFF_WG = OFF_WIN + 5120ull * 1024 * 2, OFF_WA = OFF_WG + 8ull * 512 * 128 * 2, OFF_WB = OFF_WA + 1024ull * 1024 * 2,
    OFF_WO = OFF_WB + 1024ull * 512 * 2, OFF_WUP = OFF_WO + 1024ull * 1024 * 2, OFF_WD = OFF_WUP + 5632ull * 1024 * 2, OFF_DA1 = OFF_WD + 1024ull * 2816 * 2,
    OFF_DA3S = OFF_DA1 + 128 * 128 * 2, OFF_DA3L = OFF_DA3S + 64 * 128 * 2, OFF_TW4 = OFF_DA3L + 128 * 256 * 2, OFF_TW8 = OFF_TW4 + 4096 * 8, OFF_MOD = OFF_TW8 + 8192 * 8,
    OFF_ST1 = OFF_MOD + 18 * 6144 * 4, OFF_ST2 = OFF_ST1 + NTOK * 4, OFF_AGG = OFF_ST2 + NTOK * 4, OFF_CAR = OFF_AGG + 640ull * 2 * 1024 * 8, OFF_LC = OFF_CAR + 640ull * 2 * 1024 * 4, OFF_BAR = OFF_LC + 2048 * 16, OFF_SMALL_END = OFF_BAR + 16384;
constexpr size_t OFF_BIG = 67108864ull, REG_BYTES = (size_t)NTOK * 1024 * 2;
static_assert(OFF_SMALL_END <= OFF_BIG, "small region overflow");
#define REG(i) (OFF_BIG + (size_t)(i) * REG_BYTES)

struct Params {
    const float *x_prompt, *x_sample, *c_prompt, *c_sample, *w_ada, *b_ada, *g_pre_mix, *w_in, *conv_w, *conv_b, *w_lru_a, *b_lru_a, *w_lru_x, *b_lru_x, *lru_lambda,
        *w_a_out, *w_b_out, *w_o, *g_post_mix, *g_pre_ffn, *w_up, *ffn_conv_w, *ffn_conv_b, *w_down, *g_post_ffn;
    float* out; unsigned char* ws; int ph_lo, ph_hi;
};

__device__ __forceinline__ float bf2f(unsigned v) { return __uint_as_float(v << 16); }
__device__ __forceinline__ float bflo(unsigned v) { return __uint_as_float(v << 16); }
__device__ __forceinline__ float bfhi(unsigned v) { return __uint_as_float(v & 0xffff0000u); }
__device__ __forceinline__ bf16_t f2bf(float f) { unsigned u = __float_as_uint(f); u += 0x7FFFu + ((u >> 16) & 1u); return (bf16_t)(u >> 16); }
__device__ __forceinline__ float sigm(float x) { return __builtin_amdgcn_rcpf(1.0f + __expf(-x)); }
__device__ __forceinline__ float gelu_t(float x) { const float u = x * __builtin_fmaf(x * x, -0.10294324f, -2.3022082f); return x * __builtin_amdgcn_rcpf(1.0f + __builtin_amdgcn_exp2f(u)); }
__device__ __forceinline__ float wave_sum(float v) {
#pragma unroll
    for (int o = 32; o >= 1; o >>= 1) v += __shfl_xor(v, o);
    return v;
}
__device__ __forceinline__ int seq_of_tok(int tok) { return tok < NPR ? (tok >> 12) : 16 + ((tok - NPR) >> 13); }
__device__ __forceinline__ const float* xrow(const Params& p, int tok) { return tok < NPR ? p.x_prompt + (size_t)tok * 1024 : p.x_sample + (size_t)(tok - NPR) * 1024; }

__device__ __forceinline__ int klog_of(int pp) { return 32 * (pp >> 5) + (pp & 3) + 4 * ((pp >> 3) & 3) + 16 * ((pp >> 2) & 1); }

__device__ __forceinline__ void transpose_tile(const float* __restrict__ src, int ld, int sc0, int k0, bf16_t* __restrict__ dst, int K, int dr0, LAS float* tile) {
    const int t = threadIdx.x;
    {
        const int r = t >> 4, c4 = t & 15;
#pragma unroll
        for (int i = 0; i < 2; ++i) {
            const float4 v = *(const float4*)(src + (size_t)(k0 + r + 32 * i) * ld + sc0 + 4 * c4);
            LAS float* d = tile + (r + 32 * i) * 65 + 4 * c4; d[0] = v.x; d[1] = v.y; d[2] = v.z; d[3] = v.w;
        }
    }
    __syncthreads();
    {
        const int n = t >> 3, kc = t & 7; float f[8];
#pragma unroll
        for (int j = 0; j < 8; ++j) f[j] = tile[(8 * kc + j) * 65 + n];
        u32x4v o; o.x = cvt_pk_bf16(f[0], f[1]); o.y = cvt_pk_bf16(f[2], f[3]); o.z = cvt_pk_bf16(f[4], f[5]); o.w = cvt_pk_bf16(f[6], f[7]);
        *(u32x4v*)(dst + (size_t)(dr0 + n) * K + k0 + 8 * kc) = o;
    }
    __syncthreads();
}

__device__ __forceinline__ void prep_phase(const Params& p, LAS unsigned char* lds) {
    const int tid = threadIdx.x;
    unsigned char* ws = p.ws;
    bf16_t* WinT = (bf16_t*)(ws + OFF_WIN);
    {
        const int gtid = blockIdx.x * 512 + tid, gsz = gridDim.x * 512;
        bf16_t* A1 = (bf16_t*)(ws + OFF_DA1); bf16_t* A3S = (bf16_t*)(ws + OFF_DA3S); bf16_t* A3L = (bf16_t*)(ws + OFF_DA3L);
        for (int i = gtid; i < 128 * 128; i += gsz) {
            const int row = i >> 7, pp = i & 127, kl = klog_of(pp), k1 = row >> 1, po = row & 1, pin = kl >> 6, s1 = kl & 63;
            float s, c; sincospif((float)((k1 * s1) & 63) * (1.0f / 32.0f), &s, &c);
            const float v = po == 0 ? (pin == 0 ? c : s) : (pin == 0 ? -s : c);
            A1[i] = f2bf(v);
        }
        for (int i = gtid; i < 64 * 128; i += gsz) {
            const int k2 = i >> 7, pp = i & 127, kl = klog_of(pp), pin = kl >> 6, s2 = kl & 63;
            float s, c; sincospif((float)((k2 * s2) & 63) * (1.0f / 32.0f), &s, &c);
            A3S[i] = f2bf(pin == 0 ? c : s);
        }
        for (int i = gtid; i < 128 * 256; i += gsz) {
            const int k2 = i >> 8, pp = i & 255, kl = klog_of(pp), pin = kl >> 7, s2 = kl & 127;
            float s, c; sincospif((float)((k2 * s2) & 127) * (1.0f / 64.0f), &s, &c);
            A3L[i] = f2bf(pin == 0 ? c : s);
        }
        float2* tw4 = (float2*)(ws + OFF_TW4); float2* tw8 = (float2*)(ws + OFF_TW8);
        for (int i = gtid; i < 4096; i += gsz) { float s, c; sincospif((float)i * (1.0f / 2048.0f), &s, &c); tw4[i] = make_float2(c, s); }
        for (int i = gtid; i < 8192; i += gsz) { float s, c; sincospif((float)i * (1.0f / 4096.0f), &s, &c); tw8[i] = make_float2(c, s); }
        float* st = (float*)(ws + OFF_ST1);
        for (int i = gtid; i < 2 * NTOK; i += gsz) st[i] = 0.f;
        float4* lc = (float4*)(ws + OFF_LC);
        for (int i = gtid; i < 2048; i += gsz) lc[i] = make_float4(8.0f * 1.4426950408889634f * log1pf(__expf(-p.lru_lambda[i])), -1.4426950408889634f * p.b_lru_a[i], -1.4426950408889634f * p.b_lru_x[i], 0.f);
    }
    constexpr int N_MOD = 96, N_Z = 64, N_TR = 3904;
    for (int it = blockIdx.x; it < N_MOD + N_Z + N_TR; it += gridDim.x) {
        if (it < N_MOD) {
            LAS float* sc = (LAS float*)lds;
            LAS float* red = (LAS float*)(lds + 73728);
            for (int i = tid; i < 18 * 1024; i += 512) { const int b = i >> 10, k = i & 1023; const float c = b < 16 ? p.c_prompt[b * 1024 + k] : p.c_sample[(b - 16) * 1024 + k]; sc[i] = c * sigm(c); }
            __syncthreads();
            const int col = tid & 63, kg = tid >> 6, n0 = it * 64;
            float acc[18];
#pragma unroll
            for (int b = 0; b < 18; ++b) acc[b] = 0.f;
#pragma unroll 4
            for (int i = 0; i < 128; ++i) {
                const int k = kg * 128 + i; const float w = p.w_ada[(size_t)k * 6144 + n0 + col];
#pragma unroll
                for (int b = 0; b < 18; ++b) acc[b] += sc[b * 1024 + k] * w;
            }
#pragma unroll
            for (int b = 0; b < 18; ++b) red[(kg * 18 + b) * 64 + col] = acc[b];
            __syncthreads();
            float* mod = (float*)(ws + OFF_MOD);
            for (int i = tid; i < 18 * 64; i += 512) { const int b = i >> 6, c = i & 63; float s = p.b_ada[n0 + c];
#pragma unroll
                for (int g = 0; g < 8; ++g) s += red[(g * 18 + b) * 64 + c];
                mod[b * 6144 + n0 + c] = s; }
            __syncthreads();
        } else if (it < N_MOD + N_Z) {
            const int zi = it - N_MOD, g = zi >> 4, k0 = (zi & 15) * 64;
            LAS float* wt = (LAS float*)lds;
            LAS float* tc = (LAS float*)(lds + 64 * 129 * 4); LAS float* tsn = tc + 128;
#pragma unroll
            for (int i = 0; i < 4; ++i) { const int idx = tid + 512 * i, r = idx >> 5, c4 = idx & 31;
                const float4 v = *(const float4*)(p.w_in + (size_t)(k0 + r) * 4608 + 2048 + g * 128 + 4 * c4);
                LAS float* d = wt + r * 129 + 4 * c4; d[0] = v.x; d[1] = v.y; d[2] = v.z; d[3] = v.w; }
            if (tid < 128) { float s, c; sincospif((float)tid * (1.0f / 64.0f), &s, &c); tc[tid] = c; tsn[tid] = s; }
            __syncthreads();
            const int kin = tid & 63, mg = tid >> 6;
            for (int mi = 0; mi < 12; ++mi) { const int m = mg * 12 + mi; float aC = 0.f, aS = 0.f;
                if (m <= 64) {
#pragma unroll 8
                    for (int c = 0; c < 128; ++c) { const float w = wt[kin * 129 + c]; const int q = (m * c) & 127; aC += w * tc[q]; aS += w * tsn[q]; } }
                WinT[(size_t)(2048 + g * 96 + m) * 1024 + k0 + kin] = f2bf(aC);
                WinT[(size_t)(2048 + 384 + g * 96 + m) * 1024 + k0 + kin] = f2bf(-aS); }
            __syncthreads();
        } else {
            int j = it - N_MOD - N_Z; LAS float* tile = (LAS float*)lds;
            if (j < 512) { const int kt = j & 15, nt = j >> 4; transpose_tile(p.w_in, 4608, nt * 64, kt * 64, WinT, 1024, nt * 64, tile); continue; } j -= 512;
            if (j < 512) { const int kt = j & 15, nt = j >> 4; transpose_tile(p.w_in, 4608, 2560 + nt * 64, kt * 64, WinT, 1024, 2816 + nt * 64, tile); continue; } j -= 512;
            if (j < 256) { const int kt = j & 15, nt = j >> 4; transpose_tile(p.w_a_out, 1024, nt * 64, kt * 64, (bf16_t*)(ws + OFF_WA), 1024, nt * 64, tile); continue; } j -= 256;
            if (j < 128) { const int kt = j & 7, nt = j >> 3; transpose_tile(p.w_b_out, 1024, nt * 64, kt * 64, (bf16_t*)(ws + OFF_WB), 512, nt * 64, tile); continue; } j -= 128;
            if (j < 256) { const int kt = j & 15, nt = j >> 4; transpose_tile(p.w_o, 1024, nt * 64, kt * 64, (bf16_t*)(ws + OFF_WO), 1024, nt * 64, tile); continue; } j -= 256;
            if (j < 1408) { const int kt = j & 15, nt = j >> 4, t256 = nt >> 2, sub = nt & 3, half = sub >> 1, jj0 = (sub & 1) * 64;
                transpose_tile(p.w_up, 5632, half * 2816 + 128 * t256 + jj0, kt * 64, (bf16_t*)(ws + OFF_WUP), 1024, nt * 64, tile); continue; } j -= 1408;
            if (j < 704) { const int kt = j % 44, nt = j / 44; transpose_tile(p.w_down, 1024, nt * 64, kt * 64, (bf16_t*)(ws + OFF_WD), 2816, nt * 64, tile); continue; } j -= 704;
            { const int mat = j >> 2, kt = j & 1, nt = (j >> 1) & 1, hd = mat & 7, which = (mat >> 3) & 1, dir = mat >> 4;
              const float* src = (which ? p.w_lru_x : p.w_lru_a) + (size_t)(dir * 8 + hd) * 128 * 128;
              transpose_tile(src, 128, nt * 64, kt * 64, (bf16_t*)(ws + OFF_WG), 128, hd * 512 + (dir * 2 + which) * 128 + nt * 64, tile); }
        }
    }
}

__device__ __forceinline__ void h1_phase(const Params& p) {
    const int lane = threadIdx.x & 63, w = threadIdx.x >> 6;
    const float* mod = (const float*)(p.ws + OFF_MOD); bf16_t* h1 = (bf16_t*)p.out;
    for (int row0 = (blockIdx.x * 8 + w) * 2; row0 < NTOK; row0 += gridDim.x * 16) {
        float4 v[2][4]; float ss[2];
#pragma unroll
        for (int r = 0; r < 2; ++r) { const float* x = xrow(p, row0 + r);
#pragma unroll
            for (int i = 0; i < 4; ++i) v[r][i] = *(const float4*)(x + 4 * (lane + 64 * i)); }
#pragma unroll
        for (int r = 0; r < 2; ++r) { float s = 0.f;
#pragma unroll
            for (int i = 0; i < 4; ++i) s += v[r][i].x * v[r][i].x + v[r][i].y * v[r][i].y + v[r][i].z * v[r][i].z + v[r][i].w * v[r][i].w;
            ss[r] = s; }
#pragma unroll
        for (int o = 32; o >= 1; o >>= 1) { ss[0] += __shfl_xor(ss[0], o); ss[1] += __shfl_xor(ss[1], o); }
        const float* md = mod + seq_of_tok(row0) * 6144;
#pragma unroll
        for (int r = 0; r < 2; ++r) { const float rs = rsqrtf(ss[r] * (1.0f / 1024.0f) + RMS_EPS);
#pragma unroll
            for (int i = 0; i < 4; ++i) { const int c = 4 * (lane + 64 * i);
                const float4 g = *(const float4*)(p.g_pre_mix + c), sh = *(const float4*)(md + c), sc = *(const float4*)(md + 1024 + c);
                u32x2v o; o.x = cvt_pk_bf16(v[r][i].x * rs * g.x * (1.f + sc.x) + sh.x, v[r][i].y * rs * g.y * (1.f + sc.y) + sh.y);
                o.y = cvt_pk_bf16(v[r][i].z * rs * g.z * (1.f + sc.z) + sh.z, v[r][i].w * rs * g.w * (1.f + sc.w) + sh.w);
                *(u32x2v*)(h1 + (size_t)(row0 + r) * 1024 + c) = o; } }
    }
}
__device__ __forceinline__ void x1_phase(const Params& p) {
    const int lane = threadIdx.x & 63, w = threadIdx.x >> 6;
    const float* mod = (const float*)(p.ws + OFF_MOD); const float* st1 = (const float*)(p.ws + OFF_ST1);
    const bf16_t* mo = (const bf16_t*)(p.ws + REG(2)); bf16_t* h2 = (bf16_t*)(p.ws + REG(0));
    for (int row0 = (blockIdx.x * 8 + w) * 2; row0 < NTOK; row0 += gridDim.x * 16) {
        float4 v[2][4]; u32x2v m[2][4]; float ss[2];
#pragma unroll
        for (int r = 0; r < 2; ++r) { const float* x = xrow(p, row0 + r);
#pragma unroll
            for (int i = 0; i < 4; ++i) { const int c = 4 * (lane + 64 * i); v[r][i] = *(const float4*)(x + c); m[r][i] = *(const u32x2v*)(mo + (size_t)(row0 + r) * 1024 + c); } }
        const float* md = mod + seq_of_tok(row0) * 6144;
#pragma unroll
        for (int r = 0; r < 2; ++r) { const float rs1 = rsqrtf(st1[row0 + r] * (1.0f / 1024.0f) + RMS_EPS); float s = 0.f;
#pragma unroll
            for (int i = 0; i < 4; ++i) { const int c = 4 * (lane + 64 * i); const float4 g = *(const float4*)(p.g_post_mix + c), gt = *(const float4*)(md + 2048 + c);
                v[r][i].x += gt.x * g.x * rs1 * bflo(m[r][i].x); v[r][i].y += gt.y * g.y * rs1 * bfhi(m[r][i].x); v[r][i].z += gt.z * g.z * rs1 * bflo(m[r][i].y); v[r][i].w += gt.w * g.w * rs1 * bfhi(m[r][i].y);
                *(float4*)(p.out + (size_t)(row0 + r) * 1024 + c) = v[r][i];
                s += v[r][i].x * v[r][i].x + v[r][i].y * v[r][i].y + v[r][i].z * v[r][i].z + v[r][i].w * v[r][i].w; }
            ss[r] = s; }
#pragma unroll
        for (int o = 32; o >= 1; o >>= 1) { ss[0] += __shfl_xor(ss[0], o); ss[1] += __shfl_xor(ss[1], o); }
#pragma unroll
        for (int r = 0; r < 2; ++r) { const float rs = rsqrtf(ss[r] * (1.0f / 1024.0f) + RMS_EPS);
#pragma unroll
            for (int i = 0; i < 4; ++i) { const int c = 4 * (lane + 64 * i);
                const float4 g = *(const float4*)(p.g_pre_ffn + c), sh = *(const float4*)(md + 3072 + c), sc = *(const float4*)(md + 4096 + c);
                u32x2v o; o.x = cvt_pk_bf16(v[r][i].x * rs * g.x * (1.f + sc.x) + sh.x, v[r][i].y * rs * g.y * (1.f + sc.y) + sh.y);
                o.y = cvt_pk_bf16(v[r][i].z * rs * g.z * (1.f + sc.z) + sh.z, v[r][i].w * rs * g.w * (1.f + sc.w) + sh.w);
                *(u32x2v*)(h2 + (size_t)(row0 + r) * 1024 + c) = o; } }
    }
}
__device__ __forceinline__ void final_phase(const Params& p) {
    const int lane = threadIdx.x & 63, w = threadIdx.x >> 6;
    const float* mod = (const float*)(p.ws + OFF_MOD); const float* st2 = (const float*)(p.ws + OFF_ST2);
    const bf16_t* f = (const bf16_t*)(p.ws + REG(1));
    for (int row0 = (blockIdx.x * 8 + w) * 2; row0 < NTOK; row0 += gridDim.x * 16) {
        float4 v[2][4]; u32x2v m[2][4];
#pragma unroll
        for (int r = 0; r < 2; ++r)
#pragma unroll
            for (int i = 0; i < 4; ++i) { const int c = 4 * (lane + 64 * i); v[r][i] = *(const float4*)(p.out + (size_t)(row0 + r) * 1024 + c); m[r][i] = *(const u32x2v*)(f + (size_t)(row0 + r) * 1024 + c); }
        const float* md = mod + seq_of_tok(row0) * 6144;
#pragma unroll
        for (int r = 0; r < 2; ++r) { const float rs = rsqrtf(st2[row0 + r] * (1.0f / 1024.0f) + RMS_EPS);
#pragma unroll
            for (int i = 0; i < 4; ++i) { const int c = 4 * (lane + 64 * i); const float4 g = *(const float4*)(p.g_post_ffn + c), gt = *(const float4*)(md + 5120 + c); float4 o = v[r][i];
                o.x += gt.x * g.x * rs * bflo(m[r][i].x); o.y += gt.y * g.y * rs * bfhi(m[r][i].x); o.z += gt.z * g.z * rs * bflo(m[r][i].y); o.w += gt.w * g.w * rs * bfhi(m[r][i].y);
                *(float4*)(p.out + (size_t)(row0 + r) * 1024 + c) = o; } }
    }
}

#define EPI_LOOP_ROWS for (int ai = 0; ai < 2; ++ai) _Pragma("unroll") for (int m = 0; m < 4; ++m)
__device__ __forceinline__ u32x4v pack8(const f32x4 a, const f32x4 b) { u32x4v o; o.x = cvt_pk_bf16(a[0], a[1]); o.y = cvt_pk_bf16(a[2], a[3]); o.z = cvt_pk_bf16(b[0], b[1]); o.w = cvt_pk_bf16(b[2], b[3]); return o; }

struct EpiIn {
    static constexpr bool PERM = true, AFTER_DRAIN = false; unsigned char* ws;
    __device__ __forceinline__ void operator()(const f32x4 (&acc)[2][2][4][2], const pg8::Unit& u, int wr, int wc, int fr, int fq) const {
        const int pn = u.pn, tok0 = u.pm * 256; bf16_t* tb[2]; int ld;
        if (pn < 4) { tb[0] = (bf16_t*)(ws + REG(0)) + (size_t)tok0 * 1024 + pn * 256; tb[1] = tb[0] + 128; ld = 1024; }
        else if (pn < 8) { tb[0] = (bf16_t*)(ws + REG(1)) + (size_t)tok0 * 1024 + (pn - 4) * 256; tb[1] = tb[0] + 128; ld = 1024; }
        else if (pn < 11) { int S, s0; if (tok0 < NPR) { S = 4096; s0 = tok0 & 4095; } else { S = 8192; s0 = (tok0 - NPR) & 8191; }
            bf16_t* zb = (bf16_t*)(ws + REG(4)) + (size_t)(tok0 - s0) * 1024 + (size_t)s0 * 384; ld = 384;
#pragma unroll
            for (int bj = 0; bj < 2; ++bj) { const int zc = (pn - 8) * 256 + bj * 128, plane = zc >= 384 ? 1 : 0; tb[bj] = zb + (size_t)plane * S * 384 + (zc - plane * 384); } }
        else if (pn < 15) { tb[0] = (bf16_t*)(ws + REG(2)) + (size_t)tok0 * 1024 + (pn - 11) * 256; tb[1] = tb[0] + 128; ld = 1024; }
        else { tb[0] = (bf16_t*)(ws + REG(3)) + (size_t)tok0 * 1024 + (pn - 15) * 256; tb[1] = tb[0] + 128; ld = 1024; }
        const size_t lo = (size_t)(wr * 64 + fr) * ld + wc * 32 + 8 * fq;
#pragma unroll
        EPI_LOOP_ROWS { const size_t ro = lo + (size_t)(ai * 128 + m * 16) * ld;
#pragma unroll
            for (int bj = 0; bj < 2; ++bj) *(u32x4v*)(tb[bj] + ro) = pack8(acc[ai][bj][m][0], acc[ai][bj][m][1]); }
    }
};
struct EpiUp {
    static constexpr bool PERM = true, AFTER_DRAIN = false; bf16_t* O; int ld;
    __device__ __forceinline__ void operator()(const f32x4 (&acc)[2][2][4][2], const pg8::Unit& u, int wr, int wc, int fr, int fq) const {
        bf16_t* tb = O + (size_t)(u.pm * 256 + wr * 64 + fr) * ld + u.pn * 256 + wc * 32 + 8 * fq;
#pragma unroll
        EPI_LOOP_ROWS { bf16_t* rp = tb + (size_t)(ai * 128 + m * 16) * ld;
#pragma unroll
            for (int bj = 0; bj < 2; ++bj) *(u32x4v*)(rp + bj * 128) = pack8(acc[ai][bj][m][0], acc[ai][bj][m][1]); }
    }
};
struct EpiGateA {
    static constexpr bool PERM = true, AFTER_DRAIN = false; const bf16_t* G; bf16_t* T;
    __device__ __forceinline__ void operator()(const f32x4 (&acc)[2][2][4][2], const pg8::Unit& u, int wr, int wc, int fr, int fq) const {
        const size_t off0 = (size_t)(u.pm * 256 + wr * 64 + fr) * 1024 + u.pn * 256 + wc * 32 + 8 * fq;
        u32x4v gv[2][2][2];
#define GA_LOAD(QI) { _Pragma("unroll") for (int mm = 0; mm < 2; ++mm) _Pragma("unroll") for (int bj = 0; bj < 2; ++bj) \
            gv[(QI) & 1][mm][bj] = *(const u32x4v*)(G + off0 + (size_t)(((QI) >> 1) * 128 + (((QI) & 1) * 2 + mm) * 16) * 1024 + bj * 128); }
        GA_LOAD(0)
#pragma unroll
        for (int qi = 0; qi < 4; ++qi) { const int ai = qi >> 1;
            if (qi < 3) GA_LOAD(qi + 1)
            __builtin_amdgcn_sched_barrier(0);
#pragma unroll
            for (int mm = 0; mm < 2; ++mm)
#pragma unroll
                for (int bj = 0; bj < 2; ++bj) { const int m = (qi & 1) * 2 + mm; const size_t off = off0 + (size_t)(ai * 128 + m * 16) * 1024 + bj * 128; const u32x4v g = gv[qi & 1][mm][bj];
                    f32x4 a = acc[ai][bj][m][0], b = acc[ai][bj][m][1];
                    a[0] *= sigm(bflo(g.x)); a[1] *= sigm(bfhi(g.x)); a[2] *= sigm(bflo(g.y)); a[3] *= sigm(bfhi(g.y));
                    b[0] *= sigm(bflo(g.z)); b[1] *= sigm(bfhi(g.z)); b[2] *= sigm(bflo(g.w)); b[3] *= sigm(bfhi(g.w));
                    *(u32x4v*)(T + off) = pack8(a, b); }
            __builtin_amdgcn_sched_barrier(0); }
#undef GA_LOAD
    }
};
struct EpiGateB {
    static constexpr bool PERM = true, AFTER_DRAIN = false; const bf16_t* G; bf16_t* T;
    __device__ __forceinline__ void operator()(const f32x4 (&acc)[2][2][4][2], const pg8::Unit& u, int wr, int wc, int fr, int fq) const {
        const size_t off0 = (size_t)(u.pm * 256 + wr * 64 + fr) * 1024 + u.pn * 256 + wc * 32 + 8 * fq;
        u32x4v gv[2][2][2], tv[2][2][2];
#define GB_LOAD(QI) { _Pragma("unroll") for (int mm = 0; mm < 2; ++mm) _Pragma("unroll") for (int bj = 0; bj < 2; ++bj) { \
            const size_t o_ = off0 + (size_t)(((QI) >> 1) * 128 + (((QI) & 1) * 2 + mm) * 16) * 1024 + bj * 128; gv[(QI) & 1][mm][bj] = *(const u32x4v*)(G + o_); tv[(QI) & 1][mm][bj] = *(const u32x4v*)(T + o_); } }
        GB_LOAD(0)
#pragma unroll
        for (int qi = 0; qi < 4; ++qi) { const int ai = qi >> 1;
            if (qi < 3) GB_LOAD(qi + 1)
            __builtin_amdgcn_sched_barrier(0);
#pragma unroll
            for (int mm = 0; mm < 2; ++mm)
#pragma unroll
                for (int bj = 0; bj < 2; ++bj) { const int m = (qi & 1) * 2 + mm; const size_t off = off0 + (size_t)(ai * 128 + m * 16) * 1024 + bj * 128; const u32x4v g = gv[qi & 1][mm][bj], t = tv[qi & 1][mm][bj];
                    f32x4 a = acc[ai][bj][m][0], b = acc[ai][bj][m][1];
                    a[0] = bflo(t.x) + a[0] * sigm(bflo(g.x)); a[1] = bfhi(t.x) + a[1] * sigm(bfhi(g.x)); a[2] = bflo(t.y) + a[2] * sigm(bflo(g.y)); a[3] = bfhi(t.y) + a[3] * sigm(bfhi(g.y));
                    b[0] = bflo(t.z) + b[0] * sigm(bflo(g.z)); b[1] = bfhi(t.z) + b[1] * sigm(bfhi(g.z)); b[2] = bflo(t.w) + b[2] * sigm(bflo(g.w)); b[3] = bfhi(t.w) + b[3] * sigm(bfhi(g.w));
                    *(u32x4v*)(T + off) = pack8(a, b); }
            __builtin_amdgcn_sched_barrier(0); }
#undef GB_LOAD
    }
};
struct EpiStat {
    static constexpr bool PERM = true, AFTER_DRAIN = false; bf16_t* O; float* stat;
    __device__ __forceinline__ void operator()(const f32x4 (&acc)[2][2][4][2], const pg8::Unit& u, int wr, int wc, int fr, int fq) const {
        const int row0 = u.pm * 256 + wr * 64 + fr; const size_t off0 = (size_t)row0 * 1024 + u.pn * 256 + wc * 32 + 8 * fq;
#pragma unroll
        EPI_LOOP_ROWS { float ss = 0.f;
#pragma unroll
            for (int bj = 0; bj < 2; ++bj) { const size_t off = off0 + (size_t)(ai * 128 + m * 16) * 1024 + bj * 128; const f32x4 a = acc[ai][bj][m][0], b = acc[ai][bj][m][1];
                ss += a[0] * a[0] + a[1] * a[1] + a[2] * a[2] + a[3] * a[3] + b[0] * b[0] + b[1] * b[1] + b[2] * b[2] + b[3] * b[3];
                *(u32x4v*)(O + off) = pack8(a, b); }
            ss += __shfl_xor(ss, 16); ss += __shfl_xor(ss, 32);
            if (fq == 0) atomicAdd(stat + row0 + ai * 128 + m * 16, ss); }
    }
};
struct EpiNull { static constexpr bool PERM = true, AFTER_DRAIN = false; float* sink;
    __device__ __forceinline__ void operator()(const f32x4 (&acc)[2][2][4][2], const pg8::Unit& u, int wr, int wc, int fr, int fq) const {
        float s = 0.f;
#pragma unroll
        for (int ai = 0; ai < 2; ++ai)
#pragma unroll
            for (int bj = 0; bj < 2; ++bj)
#pragma unroll
                for (int m = 0; m < 4; ++m)
#pragma unroll
                    for (int n = 0; n < 2; ++n) s += acc[ai][bj][m][n][0] + acc[ai][bj][m][n][1] + acc[ai][bj][m][n][2] + acc[ai][bj][m][n][3];
        if (s == 12345.678f) *sink = s;
    }
};
struct SameOrder : pg8::StaticOrder { __device__ bool next(int i, pg8::Unit& u) const { const bool r = pg8::StaticOrder::next(i, u); u.pm &= 7; u.pn = 0; return r; } };
template <class Epi> __device__ __forceinline__ void run_gemm_same(LAS unsigned char* lds, const bf16_t* A, const bf16_t* Bt, int M, int N, int K, const Epi& E) {
    pg8::Gemm g; g.A = A; g.Bt = Bt; g.M = M; g.N = N; g.K = K;
    SameOrder S; S.init(M, N, (int)gridDim.x, (int)blockIdx.x);
    pg8::gemm_phase<Epi, SameOrder, false>(lds, g, S, E, nullptr);
}
template <class Epi> __device__ __forceinline__ void run_gemm(LAS unsigned char* lds, const bf16_t* A, const bf16_t* Bt, int M, int N, int K, const Epi& E) {
    pg8::Gemm g; g.A = A; g.Bt = Bt; g.M = M; g.N = N; g.K = K;
    pg8::StaticOrder S; S.init(M, N, (int)gridDim.x, (int)blockIdx.x);
    pg8::gemm_phase<Epi, pg8::StaticOrder, false>(lds, g, S, E, nullptr);
}

__device__ __forceinline__ float bperm(int byte_addr, float v) { return __int_as_float(__builtin_amdgcn_ds_bpermute(byte_addr, __float_as_int(v))); }
__device__ __forceinline__ void lru_scan(f32x4 (&acc)[8][2], int lane, int fq, float& Ptile, float& Htile) {
    const int a1 = ((lane - 16) & 63) << 2, a2 = ((lane - 32) & 63) << 2, aT = ((lane & 15) + 48) << 2;
    const bool f1 = fq >= 1, f2 = fq >= 2;
    float P[8], H[8], Pe[8], He[8], Pt[8], Ht[8];
#pragma unroll
    for (int m = 0; m < 8; ++m) { float p_ = 1.f, h_ = 0.f;
#pragma unroll
        for (int i = 0; i < 4; ++i) { const float a = acc[m][0][i], b = acc[m][1][i]; h_ = a * h_ + b; p_ *= a; }
        P[m] = p_; H[m] = h_; }
#pragma unroll
    for (int m = 0; m < 8; ++m) { const float pq = bperm(a1, P[m]), hq = bperm(a1, H[m]); const float Pp = f1 ? pq : 1.f, Hp = f1 ? hq : 0.f; H[m] = P[m] * Hp + H[m]; P[m] = P[m] * Pp; }
#pragma unroll
    for (int m = 0; m < 8; ++m) { const float pq = bperm(a2, P[m]), hq = bperm(a2, H[m]); const float Pp = f2 ? pq : 1.f, Hp = f2 ? hq : 0.f; H[m] = P[m] * Hp + H[m]; P[m] = P[m] * Pp; }
#pragma unroll
    for (int m = 0; m < 8; ++m) { const float pe = bperm(a1, P[m]), he = bperm(a1, H[m]); Pe[m] = f1 ? pe : 1.f; He[m] = f1 ? he : 0.f; Pt[m] = bperm(aT, P[m]); Ht[m] = bperm(aT, H[m]); }
    float carry = 0.f, pacc = 1.f;
#pragma unroll
    for (int m = 0; m < 8; ++m) { float h = Pe[m] * carry + He[m], pp = Pe[m] * pacc;
#pragma unroll
        for (int i = 0; i < 4; ++i) { const float a = acc[m][0][i]; h = a * h + acc[m][1][i]; pp *= a; acc[m][0][i] = h; acc[m][1][i] = pp; }
        carry = Pt[m] * carry + Ht[m]; pacc *= Pt[m]; }
    Ptile = pacc; Htile = carry;
}

__device__ __forceinline__ bf16_t f2bf_hw(float f) { return (bf16_t)(cvt_pk_bf16(f, 0.f) & 0xffffu); }
__device__ __forceinline__ void lru_phase(const Params& p, LAS unsigned char* lds) {
    int tid_ = threadIdx.x; asm volatile("" : "+v"(tid_));
    const int tid = tid_, lane = tid & 63, w = tid >> 6, fr = lane & 15, fq = lane >> 4;
    const bf16_t* xa = (const bf16_t*)(p.ws + REG(0));
    bf16_t* S0g = (bf16_t*)p.out; bf16_t* Pfg = (bf16_t*)p.out + (size_t)NTOK * 1024; bf16_t* Pbg = (bf16_t*)(p.ws + REG(5));
    const bf16_t* WgT = (const bf16_t*)(p.ws + OFF_WG);
    float2* agg = (float2*)(p.ws + OFF_AGG);
    constexpr int TS = 272;
    LAS unsigned char* raw = lds;
    LAS unsigned char* xc = lds + 34816;
    LAS unsigned char* pl = lds + 69632;
    u32x4v pre0, pre1, pre2, pre3, pre4;
#define LRU_PF1(J, DST) { const int idx_ = tid + (J) * 512, r_ = idx_ >> 4, v_ = idx_ & 15, s_ = pf_s0 - 2 + r_; DST = (u32x4v){0u, 0u, 0u, 0u}; \
        if (idx_ < 131 * 16 && s_ >= 0 && s_ < pf_S) DST = *(const u32x4v*)(xa + (size_t)(pf_tok0 - 2 + r_) * 1024 + pf_hd * 128 + v_ * 8); }
#define LRU_PREFETCH(TILE) { const int pf_hd = (TILE) & 7, pf_tok0 = ((TILE) >> 3) * 128; int pf_S, pf_s0; \
        if (pf_tok0 < NPR) { pf_S = 4096; pf_s0 = pf_tok0 & 4095; } else { pf_S = 8192; pf_s0 = (pf_tok0 - NPR) & 8191; } \
        LRU_PF1(0, pre0) LRU_PF1(1, pre1) LRU_PF1(2, pre2) LRU_PF1(3, pre3) LRU_PF1(4, pre4) }
    if ((int)blockIdx.x < 5120) LRU_PREFETCH((int)blockIdx.x)
    for (int tile = blockIdx.x; tile < 5120; tile += gridDim.x) {
        const int hd = tile & 7, cidx = tile >> 3, tok0 = cidx * 128;
#define LRU_PW1(J, SRC) { const int idx_ = tid + (J) * 512; if (idx_ < 131 * 16) *(LAS u32x4v*)(raw + (idx_ >> 4) * 256 + (idx_ & 15) * 16) = SRC; }
        LRU_PW1(0, pre0) LRU_PW1(1, pre1) LRU_PW1(2, pre2) LRU_PW1(3, pre3) LRU_PW1(4, pre4)
        __syncthreads();
        { typedef float f2 __attribute__((ext_vector_type(2))); const int v = tid & 15; f2 cw[4][4], cb[4];
#pragma unroll
            for (int e = 0; e < 4; ++e) { cb[e] = *(const f2*)(p.conv_b + hd * 128 + v * 8 + 2 * e);
#pragma unroll
                for (int k = 0; k < 4; ++k) cw[k][e] = *(const f2*)(p.conv_w + k * 1024 + hd * 128 + v * 8 + 2 * e); }
#pragma unroll 1
            for (int it = 0; it < 4; ++it) { const int t = (tid >> 4) + it * 32; f2 o[4];
#pragma unroll
                for (int e = 0; e < 4; ++e) o[e] = cb[e];
#pragma unroll
                for (int k = 0; k < 4; ++k) { const u32x4v rv = *(LAS u32x4v*)(raw + (t + k) * 256 + v * 16);
                    o[0] = cw[k][0] * (f2){bflo(rv.x), bfhi(rv.x)} + o[0]; o[1] = cw[k][1] * (f2){bflo(rv.y), bfhi(rv.y)} + o[1];
                    o[2] = cw[k][2] * (f2){bflo(rv.z), bfhi(rv.z)} + o[2]; o[3] = cw[k][3] * (f2){bflo(rv.w), bfhi(rv.w)} + o[3]; }
                u32x4v ov; ov.x = cvt_pk_bf16(o[0].x, o[0].y); ov.y = cvt_pk_bf16(o[1].x, o[1].y); ov.z = cvt_pk_bf16(o[2].x, o[2].y); ov.w = cvt_pk_bf16(o[3].x, o[3].y);
                *(LAS u32x4v*)(xc + t * TS + v * 16) = ov; } }
        __syncthreads();
        if (tile + (int)gridDim.x < 5120) LRU_PREFETCH(tile + (int)gridDim.x)
        const int chl = w * 16 + fr, ch = hd * 128 + chl;
#pragma unroll
        for (int dir = 0; dir < 2; ++dir) {
            const int rsgn = dir ? -1 : 1, rbase = dir ? 127 : 0;
            bf16x8 Bf[2][4];
#pragma unroll
            for (int g = 0; g < 2; ++g)
#pragma unroll
                for (int ks = 0; ks < 4; ++ks) Bf[g][ks] = *(const bf16x8*)(WgT + (size_t)(hd * 512 + (dir * 2 + g) * 128 + chl) * 128 + ks * 32 + fq * 8);
            f32x4 acc[8][2];
#pragma unroll
            for (int m = 0; m < 8; ++m) { acc[m][0] = (f32x4){0.f, 0.f, 0.f, 0.f}; acc[m][1] = (f32x4){0.f, 0.f, 0.f, 0.f}; }
            LAS unsigned char* xa_l = xc + (rbase + rsgn * fr) * TS + fq * 16;
#pragma unroll
            for (int m = 0; m < 8; ++m)
#pragma unroll
                for (int ks = 0; ks < 4; ++ks) { const bf16x8 a = *(LAS bf16x8*)(xa_l + rsgn * (m * 16 * TS) + ks * 64);
                    acc[m][0] = __builtin_amdgcn_mfma_f32_16x16x32_bf16(a, Bf[0][ks], acc[m][0], 0, 0, 0);
                    acc[m][1] = __builtin_amdgcn_mfma_f32_16x16x32_bf16(a, Bf[1][ks], acc[m][1], 0, 0, 0);
                    if (ks == 3 && (m & 1)) __builtin_amdgcn_sched_barrier(0); }
            const float4 lcv = ((const float4*)(p.ws + OFF_LC))[dir * 1024 + ch];
            const float c8sp = lcv.x, nba = lcv.y, nbx = lcv.z;
            LAS unsigned char* xv_l = xc + (rbase + rsgn * 4 * fq) * TS + chl * 2;
#pragma unroll
            for (int m = 0; m < 8; ++m) {
#pragma unroll
                for (int h = 0; h < 2; ++h) {
                    typedef float f2 __attribute__((ext_vector_type(2)));
                    const f2 za = {acc[m][0][2 * h], acc[m][0][2 * h + 1]}, zx = {acc[m][1][2 * h], acc[m][1][2 * h + 1]};
                    const f2 ta = za * (-1.4426950408889634f) + nba, tx = zx * (-1.4426950408889634f) + nbx;
                    f2 ea, ex; ea.x = __builtin_amdgcn_exp2f(ta.x); ea.y = __builtin_amdgcn_exp2f(ta.y); ex.x = __builtin_amdgcn_exp2f(tx.x); ex.y = __builtin_amdgcn_exp2f(tx.y);
                    ea = ea + 1.0f; ex = ex + 1.0f;
                    f2 r, ig; r.x = __builtin_amdgcn_rcpf(ea.x); r.y = __builtin_amdgcn_rcpf(ea.y); ig.x = __builtin_amdgcn_rcpf(ex.x); ig.y = __builtin_amdgcn_rcpf(ex.y);
                    const f2 la = r * (-c8sp); f2 a; a.x = __builtin_amdgcn_exp2f(la.x); a.y = __builtin_amdgcn_exp2f(la.y);
                    const f2 om = 1.0f - a * a; f2 mult; mult.x = __builtin_amdgcn_sqrtf(om.x); mult.y = __builtin_amdgcn_sqrtf(om.y);
                    f2 xv; xv.x = bf2f((unsigned)*(LAS bf16_t*)(xv_l + rsgn * ((m * 16 + 2 * h) * TS))); xv.y = bf2f((unsigned)*(LAS bf16_t*)(xv_l + rsgn * ((m * 16 + 2 * h + 1) * TS)));
                    const f2 b = mult * ig * xv;
                    acc[m][0][2 * h] = a.x; acc[m][0][2 * h + 1] = a.y; acc[m][1][2 * h] = b.x; acc[m][1][2 * h + 1] = b.y; }
                if (m & 1) __builtin_amdgcn_sched_barrier(0); }
            float Pt, Ht;
            lru_scan(acc, lane, fq, Pt, Ht);
            if (fq == 0) agg[(size_t)(cidx * 2 + dir) * 1024 + ch] = make_float2(Pt, Ht);
            LAS unsigned char* pp_l = pl + dir * (128 * TS) + (rbase + rsgn * 4 * fq) * TS + chl * 2;
            LAS unsigned char* s0_l = raw + (rbase + rsgn * 4 * fq) * TS + chl * 2;
#pragma unroll
            for (int m = 0; m < 8; ++m)
#pragma unroll
                for (int i = 0; i < 4; ++i) { const int ro = rsgn * ((m * 16 + i) * TS);
                    *(LAS bf16_t*)(pp_l + ro) = f2bf_hw(acc[m][1][i]);
                    LAS bf16_t* q = (LAS bf16_t*)(s0_l + ro);
                    *q = f2bf_hw(dir == 0 ? acc[m][0][i] : acc[m][0][i] + bf2f((unsigned)*q)); }
        }
        __syncthreads();
#pragma unroll 1
        for (int it = 0; it < 4; ++it) { const int idx = tid + it * 512, t = idx >> 4, v = idx & 15; const size_t go = (size_t)(tok0 + t) * 1024 + hd * 128 + v * 8;
            *(u32x4v*)(S0g + go) = *(LAS u32x4v*)(raw + t * TS + v * 16);
            *(u32x4v*)(Pfg + go) = *(LAS u32x4v*)(pl + t * TS + v * 16);
            *(u32x4v*)(Pbg + go) = *(LAS u32x4v*)(pl + 128 * TS + t * TS + v * 16); }
        __syncthreads();
    }
}
__device__ __forceinline__ void lru_out_phase(const Params& p) {
    bf16_t* S0g = (bf16_t*)p.out; const bf16_t* Pfg = (const bf16_t*)p.out + (size_t)NTOK * 1024; const bf16_t* Pbg = (const bf16_t*)(p.ws + REG(5));
    const bf16_t* ya = (const bf16_t*)(p.ws + REG(1)); const float* car = (const float*)(p.ws + OFF_CAR);
    for (int idx0 = blockIdx.x * 512 + threadIdx.x; idx0 < NTOK * 128; idx0 += gridDim.x * 1024) {
        u32x4v s[2], pf[2], pb[2], y[2]; size_t go[2]; float4 cfa[2], cfb[2], cba[2], cbb[2];
#pragma unroll
        for (int r = 0; r < 2; ++r) { int idx = idx0 + r * gridDim.x * 512; if (idx >= NTOK * 128) idx = idx0; const int tok = idx >> 7, c0 = (idx & 127) * 8; go[r] = (size_t)tok * 1024 + c0;
            s[r] = *(const u32x4v*)(S0g + go[r]); pf[r] = *(const u32x4v*)(Pfg + go[r]); pb[r] = *(const u32x4v*)(Pbg + go[r]); y[r] = *(const u32x4v*)(ya + go[r]);
            { const int cidx_ = tok >> 7; cfa[r] = *(const float4*)(car + (size_t)(cidx_ * 2) * 1024 + c0); cfb[r] = *(const float4*)(car + (size_t)(cidx_ * 2) * 1024 + c0 + 4);
              cba[r] = *(const float4*)(car + (size_t)(cidx_ * 2 + 1) * 1024 + c0); cbb[r] = *(const float4*)(car + (size_t)(cidx_ * 2 + 1) * 1024 + c0 + 4); } }
#pragma unroll
        for (int r = 0; r < 2; ++r) { int idx = idx0 + r * gridDim.x * 512; if (idx >= NTOK * 128) { if (r) break; idx = idx0; } const int tok = idx >> 7, c0 = (idx & 127) * 8, cidx = tok >> 7;
            const float4 cf0 = cfa[r], cf1 = cfb[r], cb0 = cba[r], cb1 = cbb[r]; (void)cidx; (void)c0;
            u32x4v o;
#define LO_E(S, PF, PB, Y, CF, CB, FN) ((FN(S) + FN(PF) * (CF) + FN(PB) * (CB)) * gelu_t(FN(Y)))
            o.x = cvt_pk_bf16(LO_E(s[r].x, pf[r].x, pb[r].x, y[r].x, cf0.x, cb0.x, bflo), LO_E(s[r].x, pf[r].x, pb[r].x, y[r].x, cf0.y, cb0.y, bfhi));
            o.y = cvt_pk_bf16(LO_E(s[r].y, pf[r].y, pb[r].y, y[r].y, cf0.z, cb0.z, bflo), LO_E(s[r].y, pf[r].y, pb[r].y, y[r].y, cf0.w, cb0.w, bfhi));
            o.z = cvt_pk_bf16(LO_E(s[r].z, pf[r].z, pb[r].z, y[r].z, cf1.x, cb1.x, bflo), LO_E(s[r].z, pf[r].z, pb[r].z, y[r].z, cf1.y, cb1.y, bfhi));
            o.w = cvt_pk_bf16(LO_E(s[r].w, pf[r].w, pb[r].w, y[r].w, cf1.z, cb1.z, bflo), LO_E(s[r].w, pf[r].w, pb[r].w, y[r].w, cf1.w, cb1.w, bfhi));
            *(u32x4v*)(S0g + go[r]) = o; }
    }
}

__device__ __forceinline__ void carry_phase(const Params& p) {
    const float2* agg = (const float2*)(p.ws + OFF_AGG); float* car = (float*)(p.ws + OFF_CAR);
    for (int i = blockIdx.x * 512 + threadIdx.x; i < 18 * 2 * 1024; i += gridDim.x * 512) {
        const int ch = i & 1023, dir = (i >> 10) & 1, seq = i >> 11;
        const int c0 = seq < 16 ? seq * 32 : 512 + (seq - 16) * 64, nc = seq < 16 ? 32 : 64;
        float c = 0.f;
        for (int j = 0; j < nc; ++j) { const int ci = c0 + (dir == 0 ? j : nc - 1 - j); const size_t o = (size_t)(ci * 2 + dir) * 1024 + ch; const float2 a = agg[o]; car[o] = c; c = a.x * c + a.y; }
    }
}

__device__ __forceinline__ u32x2v tr_read(unsigned addr) { u32x2v r; asm volatile("ds_read_b64_tr_b16 %0, %1\n\ts_waitcnt lgkmcnt(0)" : "=&v"(r) : "v"(addr) : "memory"); return r; }

template <int MT, int K, int STEP>
__device__ __forceinline__ void dft_tile(const Params& p, LAS unsigned char* Al, LAS unsigned char* Dl, int seqtok, int S, int N2, int n0, int k1) {
    const int tid = threadIdx.x, lane = tid & 63, w = tid >> 6, fr = lane & 15, fq = lane >> 4;
    constexpr int KS = K / 32, MB = MT / 16, AST = 2 * K + 16;
    const bf16_t* src0 = STEP == 1 ? (const bf16_t*)(p.ws + REG(4)) + (size_t)seqtok * 1024 + n0
                                   : (const bf16_t*)(p.ws + REG(0)) + (size_t)seqtok * 1024 + (size_t)(2 * k1) * N2 * 384 + n0;
#pragma unroll
    for (int it = 0; it < K * 16 / 512; ++it) { const int idx = tid + it * 512, kk = idx >> 4, v = idx & 15;
        size_t ro;
        if (STEP == 1) { const int part = kk >> 6, s1 = kk & 63; ro = (size_t)part * S * 384 + (size_t)(s1 * N2) * 384; }
        else { const int part = kk / (K / 2), s2 = kk % (K / 2); ro = (size_t)part * N2 * 384 + (size_t)s2 * 384; }
        *(LAS u32x4v*)(Dl + kk * 288 + v * 16) = *(const u32x4v*)(src0 + ro + v * 8); }
    __syncthreads();
    bf16x8 Bf[KS];
    { const int q = fr >> 2, pp = fr & 3; const unsigned base = (unsigned)(size_t)Dl + (unsigned)((4 * fq + q) * 288 + (16 * w + 4 * pp) * 2);
#pragma unroll
        for (int ks = 0; ks < KS; ++ks) { const u32x2v r0 = tr_read(base + (unsigned)((32 * ks) * 288)), r1 = tr_read(base + (unsigned)((32 * ks + 16) * 288));
            u32x4v t; t.x = r0.x; t.y = r0.y; t.z = r1.x; t.w = r1.y; Bf[ks] = __builtin_bit_cast(bf16x8, t); } }
    f32x4 acc[MB];
#pragma unroll
    for (int mb = 0; mb < MB; ++mb) { acc[mb] = (f32x4){0.f, 0.f, 0.f, 0.f};
#pragma unroll
        for (int ks = 0; ks < KS; ++ks) { const bf16x8 a = *(LAS bf16x8*)(Al + (16 * mb + fr) * AST + (32 * ks + 8 * fq) * 2);
            acc[mb] = __builtin_amdgcn_mfma_f32_16x16x32_bf16(a, Bf[ks], acc[mb], 0, 0, 0); } }
    const int n = n0 + 16 * w + fr;
    if (STEP == 1) {
        const float2* tw = (const float2*)(p.ws + (S == 4096 ? OFF_TW4 : OFF_TW8)); const int s2 = n / 384;
        bf16_t* o = (bf16_t*)(p.ws + REG(0)) + (size_t)seqtok * 1024 + n; const size_t rstr = (size_t)N2 * 384;
#pragma unroll
        for (int mb = 0; mb < MB; ++mb)
#pragma unroll
            for (int ii = 0; ii < 2; ++ii) { const int kk1 = 8 * mb + 2 * fq + ii; const float2 cs = tw[kk1 * s2]; const float re = acc[mb][2 * ii], im = acc[mb][2 * ii + 1];
                o[(size_t)(2 * kk1) * rstr] = f2bf(re * cs.x + im * cs.y); o[(size_t)(2 * kk1 + 1) * rstr] = f2bf(im * cs.x - re * cs.y); }
    } else {
        const int g = n / 96, mm = n - 96 * g; const float scale = rsqrtf((float)S * 128.0f);
        bf16_t* o = (bf16_t*)(p.ws + REG(4)) + (size_t)seqtok * 512 + g * 128;
#pragma unroll
        for (int mb = 0; mb < MB; ++mb)
#pragma unroll
            for (int i = 0; i < 4; ++i) { const int k2 = 16 * mb + 4 * fq + i, k = k1 + 64 * k2; const bf16_t v = f2bf(acc[mb][i] * scale);
                if (mm <= 64) o[(size_t)k * 512 + mm] = v;
                if (mm >= 1 && mm <= 63) o[(size_t)((S - k) & (S - 1)) * 512 + 128 - mm] = v; }
    }
    __syncthreads();
}
__device__ __forceinline__ void dft_loadA(LAS unsigned char* Al, const bf16_t* Ag, int MT, int K) {
    const int vpr = K / 8, total = MT * vpr;
    for (int idx = threadIdx.x; idx < total; idx += 512) { const int r = idx / vpr, v = idx % vpr; *(LAS u32x4v*)(Al + r * (2 * K + 16) + v * 16) = *(const u32x4v*)(Ag + (size_t)r * K + v * 8); }
}
__device__ __forceinline__ void dft_phase(const Params& p, LAS unsigned char* lds, int step) {
    LAS unsigned char* Al = lds; LAS unsigned char* Dl = lds + 67584;
    int curA = -1;
    if (step == 1) {
        dft_loadA(Al, (const bf16_t*)(p.ws + OFF_DA1), 128, 128);
        for (int tile = blockIdx.x; tile < 3840; tile += gridDim.x) {
            int seq, ti, S, N2; if (tile < 768) { seq = 16 + tile / 384; ti = tile % 384; S = 8192; N2 = 128; } else { const int t2 = tile - 768; seq = t2 / 192; ti = t2 % 192; S = 4096; N2 = 64; }
            const int seqtok = seq < 16 ? seq * 4096 : NPR + (seq - 16) * 8192;
            dft_tile<128, 128, 1>(p, Al, Dl, seqtok, S, N2, ti * 128, 0);
        }
    } else {
        for (int tile = blockIdx.x; tile < 3456; tile += gridDim.x) {
            if (tile < 384) { const int seq = 16 + tile / 192, r = tile % 192, k1 = r / 3, n0 = (r % 3) * 128;
                if (curA != 2) { __syncthreads(); dft_loadA(Al, (const bf16_t*)(p.ws + OFF_DA3L), 128, 256); curA = 2; }
                dft_tile<128, 256, 3>(p, Al, Dl, NPR + (seq - 16) * 8192, 8192, 128, n0, k1);
            } else { const int t2 = tile - 384, seq = t2 / 192, r = t2 % 192, k1 = r / 3, n0 = (r % 3) * 128;
                if (curA != 1) { __syncthreads(); dft_loadA(Al, (const bf16_t*)(p.ws + OFF_DA3S), 64, 128); curA = 1; }
                dft_tile<64, 128, 3>(p, Al, Dl, seq * 4096, 4096, 64, n0, k1);
            }
        }
    }
    __syncthreads();
}

typedef float f32x2v __attribute__((ext_vector_type(2)));
__device__ __forceinline__ f32x2v up2(unsigned v) { f32x2v r; r.x = __uint_as_float(v << 16); r.y = __uint_as_float(v & 0xffff0000u); return r; }
__device__ __forceinline__ void unpack8v(const u32x4v v, f32x2v (&f)[4]) { f[0] = up2(v.x); f[1] = up2(v.y); f[2] = up2(v.z); f[3] = up2(v.w); }
__device__ __forceinline__ f32x2v gelu2(f32x2v x) {
    const f32x2v u = x * (x * x * (-0.10294324f) + (-2.3022082f));
    f32x2v e; e.x = __builtin_amdgcn_exp2f(u.x); e.y = __builtin_amdgcn_exp2f(u.y);
    const f32x2v d = e + 1.0f; f32x2v r; r.x = __builtin_amdgcn_rcpf(d.x); r.y = __builtin_amdgcn_rcpf(d.y);
    return x * r;
}
__device__ __forceinline__ void convgelu_phase(const Params& p, int row0, int nrows) {
    constexpr int PC = 5632; const bf16_t* up = (const bf16_t*)(p.ws + REG(1)); bf16_t* gout = (bf16_t*)(p.ws + REG(3));
    const int total = (nrows / 32) * 22 * 16;
    for (int idx = blockIdx.x * 512 + threadIdx.x; idx < total; idx += gridDim.x * 512) {
        const int v = idx & 15, q = idx >> 4, nl = q % 22, run = q / 22, j0 = 128 * nl + 8 * v, tl = run * 32, t0 = row0 + tl;
        int S, s0; if (t0 < NPR) { S = 4096; s0 = t0 & 4095; } else { S = 8192; s0 = (t0 - NPR) & 8191; }
        f32x2v wv[3][4], wg[3][4], bv[4], bg[4];
#pragma unroll
        for (int e = 0; e < 4; ++e) { bv[e] = *(const f32x2v*)(p.ffn_conv_b + j0 + 2 * e); bg[e] = *(const f32x2v*)(p.ffn_conv_b + 2816 + j0 + 2 * e);
#pragma unroll
            for (int k = 0; k < 3; ++k) { wv[k][e] = *(const f32x2v*)(p.ffn_conv_w + k * 5632 + j0 + 2 * e); wg[k][e] = *(const f32x2v*)(p.ffn_conv_w + k * 5632 + 2816 + j0 + 2 * e); } }
        const bf16_t* base = up + (size_t)tl * PC + nl * 256 + 8 * v;
        f32x2v av[4], ag[4], bvf[4], bgf[4];
        { u32x4v a0 = {0u, 0u, 0u, 0u}, a1 = {0u, 0u, 0u, 0u};
          if (s0 > 0) { a0 = *(const u32x4v*)(base - PC); a1 = *(const u32x4v*)(base - PC + 128); }
          unpack8v(a0, av); unpack8v(a1, ag); unpack8v(*(const u32x4v*)(base), bvf); unpack8v(*(const u32x4v*)(base + 128), bgf); }
#pragma unroll 8
        for (int tt = 0; tt < 32; ++tt) {
            u32x4v c0 = {0u, 0u, 0u, 0u}, c1 = {0u, 0u, 0u, 0u};
            if (s0 + tt + 1 < S) { c0 = *(const u32x4v*)(base + (size_t)(tt + 1) * PC); c1 = *(const u32x4v*)(base + (size_t)(tt + 1) * PC + 128); }
            f32x2v cvf[4], cgf[4], o[4]; unpack8v(c0, cvf); unpack8v(c1, cgf);
#pragma unroll
            for (int e = 0; e < 4; ++e) { const f32x2v ov = wv[2][e] * cvf[e] + (wv[1][e] * bvf[e] + (wv[0][e] * av[e] + bv[e]));
                const f32x2v og = wg[2][e] * cgf[e] + (wg[1][e] * bgf[e] + (wg[0][e] * ag[e] + bg[e]));
                o[e] = gelu2(og) * ov; av[e] = bvf[e]; ag[e] = bgf[e]; bvf[e] = cvf[e]; bgf[e] = cgf[e]; }
            u32x4v ov4; ov4.x = cvt_pk_bf16(o[0].x, o[0].y); ov4.y = cvt_pk_bf16(o[1].x, o[1].y); ov4.z = cvt_pk_bf16(o[2].x, o[2].y); ov4.w = cvt_pk_bf16(o[3].x, o[3].y);
            *(u32x4v*)(gout + (size_t)(t0 + tt) * 2816 + j0) = ov4;
        }
    }
}

constexpr int N_PHASES = 20;
#ifndef PH_MASK
#define PH_MASK 0xFFFFFFFFu
#endif
#define EN(n) ((PH_MASK >> (n)) & 1u)
#ifndef ONE_LAUNCH
#define ONE_LAUNCH 1
#endif
#define XB_TMO      128
#define XB_XCNT(j)  (256  + 64 * (j))
#define XB_XSUB(j)  (1280 + 64 * (j))
#define XB_XGEN(j)  (2304 + 64 * (j))
#define XB_TOP      3328
#define XB_TOPGEN   3392
#define XCD_BAR_WORDS 3456
#define XB_SPIN_CAP (1u << 18)

__device__ __forceinline__ unsigned xb_ld(unsigned* p)              { return __hip_atomic_load(p, __ATOMIC_RELAXED, __HIP_MEMORY_SCOPE_AGENT); }
__device__ __forceinline__ unsigned xb_add(unsigned* p, unsigned v) { return __hip_atomic_fetch_add(p, v, __ATOMIC_RELAXED, __HIP_MEMORY_SCOPE_AGENT); }
__device__ __forceinline__ unsigned xb_xcc_id() { return (unsigned)__builtin_amdgcn_s_getreg((3 << 11) | 20) & 0xFu; }
#define XB_SPIN(cond, bar) do { unsigned _sp = 0; while (cond) { __builtin_amdgcn_s_sleep(1); \
    if ((++_sp & 255u) == 0u) { if (xb_ld(&(bar)[XB_TMO])) break; if (_sp > XB_SPIN_CAP) { atomicAdd(&(bar)[XB_TMO], 1u); break; } } } } while (0)

struct XcdBarrier {
    unsigned* bar; unsigned x;
    volatile LAS unsigned* st;
};

__device__ __forceinline__ XcdBarrier xcd_barrier_post(unsigned* bar, volatile LAS unsigned* st) {
    XcdBarrier b; b.bar = bar; b.x = xb_xcc_id(); b.st = st;
    if (threadIdx.x == 0) (void)xb_add(&bar[XB_XCNT(b.x)], 1u);
    return b;
}
__device__ __forceinline__ void xcd_barrier_complete(unsigned* bar, unsigned x, unsigned& nloc, unsigned& nx) {
    const unsigned G = gridDim.x * gridDim.y * gridDim.z;
    unsigned sum, cnt, mine, sp = 0u;
    for (;;) {
        sum = 0u; cnt = 0u; mine = 0u;
#pragma unroll
        for (unsigned j = 0; j < 16; ++j) { const unsigned c = xb_ld(&bar[XB_XCNT(j)]); sum += c; cnt += (c > 0u) ? 1u : 0u; mine = (j == x) ? c : mine; }
        if (sum == G) break;
        __builtin_amdgcn_s_sleep(1);
        if ((++sp & 255u) == 0u) { if (xb_ld(&bar[XB_TMO])) break; if (sp > XB_SPIN_CAP) { atomicAdd(&bar[XB_TMO], 1u); break; } }
    }
    nloc = mine > 0u ? mine : 1u; nx = cnt > 0u ? cnt : 1u;
}

__device__ __forceinline__ void xcd_barrier(const XcdBarrier& b) {
    asm volatile("s_waitcnt vmcnt(0)" ::: "memory");
    __syncthreads();
    if (threadIdx.x == 0) {
        unsigned* bar = b.bar;
        __builtin_amdgcn_s_waitcnt(0);
        unsigned nloc = b.st[0], nx = b.st[1];
        if (nloc == 0u) { xcd_barrier_complete(bar, b.x, nloc, nx); b.st[0] = nloc; b.st[1] = nx; }
        const unsigned old = xb_add(&bar[XB_XSUB(b.x)], 1u);
        const unsigned gen = old / nloc;
        if (old + 1u == (gen + 1u) * nloc) {
            __builtin_amdgcn_fence(__ATOMIC_RELEASE, "agent");
            asm volatile("s_waitcnt vmcnt(0)" ::: "memory");
            const unsigned og = xb_add(&bar[XB_TOP], 1u);
            const unsigned tg = og / nx;
            if (og + 1u == (tg + 1u) * nx) xb_add(&bar[XB_TOPGEN], 1u);
            else XB_SPIN(xb_ld(&bar[XB_TOPGEN]) == tg, bar);
            __builtin_amdgcn_fence(__ATOMIC_ACQUIRE, "agent");
            xb_add(&bar[XB_XGEN(b.x)], 1u);
            asm volatile("s_waitcnt vmcnt(0)" ::: "memory");
        } else {
            XB_SPIN(xb_ld(&bar[XB_XGEN(b.x)]) == gen, bar);
            __builtin_amdgcn_fence(__ATOMIC_ACQUIRE, "agent");
            asm volatile("s_waitcnt vmcnt(0)" ::: "memory");
        }
    }
    __syncthreads();
}


__device__ __forceinline__ void grid_bar(unsigned* ctr, unsigned target) {
    __syncthreads();
    if (threadIdx.x == 0) {
        __builtin_amdgcn_fence(__ATOMIC_RELEASE, "agent");
        __hip_atomic_fetch_add(ctr, 1u, __ATOMIC_RELAXED, __HIP_MEMORY_SCOPE_AGENT);
        while (__hip_atomic_load(ctr, __ATOMIC_RELAXED, __HIP_MEMORY_SCOPE_AGENT) < target) __builtin_amdgcn_s_sleep(2);
        __builtin_amdgcn_fence(__ATOMIC_ACQUIRE, "agent");
        asm volatile("s_waitcnt vmcnt(0)" ::: "memory");
    }
    __syncthreads();
}
template <int PH> __device__ __forceinline__ void run_phase(const Params& p, LAS unsigned char* lds) {
    unsigned char* ws = p.ws;
    if constexpr (PH == 0) { if (EN(0)) prep_phase(p, lds); }
    else if constexpr (PH == 1) { if (EN(1)) h1_phase(p); }
    else if constexpr (PH == 2) { if (EN(2)) { EpiIn E; E.ws = ws; run_gemm(lds, (const bf16_t*)p.out, (const bf16_t*)(ws + OFF_WIN), NTOK, 4864, 1024, E); }
#ifdef PROBE_NULLGEMM
        __syncthreads(); { EpiNull E; E.sink = (float*)(ws + OFF_ST1); run_gemm_same(lds, (const bf16_t*)p.out, (const bf16_t*)(ws + OFF_WIN), NTOK, 5120, 1024, E); }
#endif
    }
    else if constexpr (PH == 3) { if (EN(3)) lru_phase(p, lds); }
    else if constexpr (PH == 4) { if (EN(4)) carry_phase(p); if (EN(18)) dft_phase(p, lds, 1); }
    else if constexpr (PH == 5) { if (EN(5)) lru_out_phase(p); if (EN(19)) dft_phase(p, lds, 3); }
    else if constexpr (PH == 6) { if (EN(6)) { EpiGateA E; E.G = (const bf16_t*)(ws + REG(2)); E.T = (bf16_t*)(ws + REG(0)); run_gemm(lds, (const bf16_t*)p.out, (const bf16_t*)(ws + OFF_WA), NTOK, 1024, 1024, E); }
        __syncthreads();
        if (EN(7)) { EpiGateB E; E.G = (const bf16_t*)(ws + REG(3)); E.T = (bf16_t*)(ws + REG(0)); run_gemm(lds, (const bf16_t*)(ws + REG(4)), (const bf16_t*)(ws + OFF_WB), NTOK, 1024, 512, E); } }
    else if constexpr (PH == 7) { }
    else if constexpr (PH == 8) { if (EN(8)) { EpiStat E; E.O = (bf16_t*)(ws + REG(2)); E.stat = (float*)(ws + OFF_ST1); run_gemm(lds, (const bf16_t*)(ws + REG(0)), (const bf16_t*)(ws + OFF_WO), NTOK, 1024, 1024, E); } }
    else if constexpr (PH == 9) { if (EN(9)) x1_phase(p); }
    else if constexpr (PH == 10 || PH == 12 || PH == 14 || PH == 16) { if (EN(10)) { constexpr int part = (PH - 10) >> 1, row0 = part * 20480;
        EpiUp E; E.O = (bf16_t*)(ws + REG(1)); E.ld = 5632; run_gemm(lds, (const bf16_t*)(ws + REG(0)) + (size_t)row0 * 1024, (const bf16_t*)(ws + OFF_WUP), 20480, 5632, 1024, E); } }
    else if constexpr (PH == 11 || PH == 13 || PH == 15 || PH == 17) { if (EN(11)) { constexpr int part = (PH - 11) >> 1; convgelu_phase(p, part * 20480, 20480); } }
    else if constexpr (PH == 18) { if (EN(16)) { EpiStat E; E.O = (bf16_t*)(ws + REG(1)); E.stat = (float*)(ws + OFF_ST2); run_gemm(lds, (const bf16_t*)(ws + REG(3)), (const bf16_t*)(ws + OFF_WD), NTOK, 1024, 2816, E); } }
    else if constexpr (PH == 19) { if (EN(17)) final_phase(p); }
}
__global__ void __launch_bounds__(512, 2) mega_kernel(Params p) {
    extern __shared__ __attribute__((aligned(16))) unsigned char shm[];
    LAS unsigned char* lds = (LAS unsigned char*)shm;
#if ONE_LAUNCH
    cg::grid_group grid = cg::this_grid();
    volatile LAS unsigned* st = (volatile LAS unsigned*)(lds + LDS_BYTES - 16);
    if (threadIdx.x == 0) { st[0] = 0u; st[1] = 0u; }
    __syncthreads();
    const XcdBarrier xb = xcd_barrier_post((unsigned*)(p.ws + OFF_BAR), st);
#ifndef REPEAT_MASK
#define REPEAT_MASK 0u
#endif
#define PHS(n, k) run_phase<n>(p, lds); if ((REPEAT_MASK >> (n)) & 1u) { xcd_barrier(xb); run_phase<n>(p, lds); } xcd_barrier(xb);
    if (p.ph_hi < 0) grid.sync();
    run_phase<0>(p, lds); xcd_barrier(xb);
    PHS(1, 1) PHS(2, 2) PHS(3, 3) PHS(4, 4) PHS(5, 5) PHS(6, 6) PHS(8, 8) PHS(9, 9) PHS(10, 10) PHS(11, 11) PHS(12, 12) PHS(13, 13) PHS(14, 14) PHS(15, 15) PHS(16, 16) PHS(17, 17) PHS(18, 18)
    run_phase<19>(p, lds);
#else
#define PHC(n) case n: run_phase<n>(p, lds); break;
    switch (p.ph_lo) { PHC(0) PHC(1) PHC(2) PHC(3) PHC(4) PHC(5) PHC(6) PHC(7) PHC(8) PHC(9) PHC(10) PHC(11) PHC(12) PHC(13) PHC(14) PHC(15) PHC(16) PHC(17) PHC(18) PHC(19) }
#endif
}

extern "C" void kernel_launch(void* const* d_in, const int* in_sizes, int n_in, void* d_out, int out_size, void* d_ws, size_t ws_size, hipStream_t stream) {
    static int grid = 0;
    if (grid == 0) {
        if (ws_size < OFF_BIG + 6 * REG_BYTES) { fprintf(stderr, "kernel_launch: workspace too small (%zu)\n", ws_size); grid = -1; return; }
        int dev = 0, cus = 0, per_cu = 0;
        hipGetDevice(&dev); hipDeviceGetAttribute(&cus, hipDeviceAttributeMultiprocessorCount, dev);
        if (hipFuncSetAttribute((const void*)mega_kernel, hipFuncAttributeMaxDynamicSharedMemorySize, LDS_BYTES) != hipSuccess) { fprintf(stderr, "kernel_launch: hipFuncSetAttribute failed\n"); grid = -1; return; }
        if (hipOccupancyMaxActiveBlocksPerMultiprocessor(&per_cu, (const void*)mega_kernel, 512, LDS_BYTES) != hipSuccess || per_cu < 1) { fprintf(stderr, "kernel_launch: occupancy query gave %d\n", per_cu); per_cu = 1; }
        (void)hipGetLastError();
        grid = cus * per_cu;
    }
    if (grid < 0) return;
    Params p{};
    const float** pp = (const float**)&p;
    for (int i = 0; i < 25; ++i) pp[i] = (const float*)d_in[i];
    p.out = (float*)d_out; p.ws = (unsigned char*)d_ws;
#if ONE_LAUNCH
    p.ph_lo = 0; p.ph_hi = N_PHASES;
    (void)hipMemsetAsync((unsigned char*)d_ws + OFF_BAR, 0, 16384, stream);
    void* args[] = {&p};
    hipError_t e = hipLaunchCooperativeKernel((const void*)mega_kernel, dim3(grid), dim3(512), args, LDS_BYTES, stream);
    if (e != hipSuccess) fprintf(stderr, "cooperative launch failed: %s (grid %d)\n", hipGetErrorString(e), grid);
#else
    for (int ph = 0; ph < N_PHASES; ++ph) { p.ph_lo = ph; p.ph_hi = ph + 1; hipLaunchKernelGGL(mega_kernel, dim3(grid), dim3(512), LDS_BYTES, stream, p); }
#endif
}
```

```cpp
#include <hip/hip_runtime.h>
#include <hip/hip_cooperative_groups.h>
#include <cstdio>
namespace cg = cooperative_groups;

namespace pg8 {
#define PG8_LAS __attribute__((address_space(3)))
typedef unsigned short bf16_t;
typedef short bf16x8 __attribute__((ext_vector_type(8)));
typedef float f32x4 __attribute__((ext_vector_type(4)));
typedef unsigned u32x4 __attribute__((ext_vector_type(4)));
constexpr int BM = 256, BK = 64, HALF = 128, HTB = HALF * BK * 2  , STAGE_BYTES = 8 * HTB, NXCD = 8, WGM = 8;

__host__ __device__ __forceinline__ int lds_byte(int r, int c) { const int st = (r >> 4) * 2 + (c >> 5), rr = r & 15, cc = c & 31, ob = rr * 64 + cc * 2; return st * 1024 + (ob ^ (((ob >> 9) & 1) << 5)); }
__host__ __device__ __forceinline__ void stage_rc(int b, int& R, int& C) { const int st = b / 1024, sb = b % 1024, swz = sb ^ (((sb >> 9) & 1) << 5); R = (st >> 1) * 16 + swz / 64; C = (st & 1) * 32 + (swz % 64) / 2; }
__host__ __device__ __forceinline__ int perm32(int rho) { const int n = rho >> 4, i = rho & 15; return 8 * (i >> 2) + 4 * n + (i & 3); }

struct Unit { int pm, pn; };
struct Gemm { const bf16_t* A; const bf16_t* Bt; int M, N, K; };

struct StaticOrder {
    int nM, nN, nwg, G, c;
    __host__ __device__ void init(int M, int N, int G_, int c_) { nM = M / BM; nN = N / BM; nwg = nM * nN; G = G_; c = c_; }
    __host__ __device__ bool next(int i, Unit& u) const {
        const long L = (long)i * G + c; if (L >= nwg) return false;
        int wgid = (int)L; { const int q = nwg / NXCD, r = nwg % NXCD, xcd = wgid % NXCD, off = wgid / NXCD; wgid = (xcd < r ? xcd * (q + 1) : r * (q + 1) + (xcd - r) * q) + off; }
        const int nig = WGM * nN, gid = wgid / nig, fm = gid * WGM, gsz = (nM - fm) < WGM ? (nM - fm) : WGM;
        u.pm = fm + ((wgid % nig) % gsz); u.pn = (wgid % nig) / gsz; return true;
    }
    __device__ __forceinline__ void a_ready(const Unit&) const {}
    __device__ __forceinline__ void done(const Unit&) const {}
};
__device__ __forceinline__ unsigned cvt_pk_bf16(float lo, float hi) { unsigned r; asm volatile("v_cvt_pk_bf16_f32 %0, %1, %2" : "=v"(r) : "v"(lo), "v"(hi)); return r; }
typedef float f32x2 __attribute__((ext_vector_type(2)));
template <class Epi, class Sched, bool STAMP = false>
__device__ __forceinline__ void gemm_phase(PG8_LAS unsigned char* lds, const Gemm g, const Sched& S, const Epi& E, unsigned long long* stamps) {
    int tid_ = threadIdx.x; asm volatile("" : "+v"(tid_));
    const int tid = tid_, wid = __builtin_amdgcn_readfirstlane(tid >> 6), lane = tid & 63, wr = wid >> 2, wc = wid & 3, fr = lane & 15, fq = lane >> 4;
    const int K = g.K, nt = K / BK;
    int ts_lo = 0, ts_hi = 0, nts = 0; const unsigned long long rt_entry = STAMP ? (unsigned long long)wall_clock64() : 0ull;
#define PG8_STAMP() do { if (STAMP && wid == 0 && nts < 64) { const unsigned long long _c = (unsigned long long)clock64(); \
        ts_lo = (lane == nts) ? (int)(unsigned)_c : ts_lo; ts_hi = (lane == nts) ? (int)(unsigned)(_c >> 32) : ts_hi; ++nts; } } while (0)
    PG8_STAMP();
    unsigned voffA[2], voffB[2];
#pragma unroll
    for (int i = 0; i < 2; ++i) { int R, C; stage_rc(tid * 16 + i * 8192, R, C); const int Rb = Epi::PERM ? ((R & ~31) + perm32(R & 31)) : R;
        voffA[i] = (unsigned)(R * K + C) * 2u; voffB[i] = (unsigned)(Rb * K + C) * 2u; }
    const size_t kstep = (size_t)(BK * 2);
    const size_t hstep = (size_t)HALF * K * 2;
    const size_t tstep = 2 * hstep;
    const unsigned ldsw = (unsigned)wid * 1024u;
    const int aoff = lds_byte(wr * 64 + fr, fq * 8), boff = lds_byte(wc * 32 + fr, fq * 8);
#define PG8_SA(b, h) (((b) * 2 + (h)) * HTB)
#define PG8_SB(b, h) ((4 + (b) * 2 + (h)) * HTB)
#define PG8_STAGE(bufoff, gbase, voff) do { _Pragma("unroll") for (int _i = 0; _i < 2; ++_i) \
        __builtin_amdgcn_global_load_lds((const unsigned*)((const char*)(gbase) + (voff)[_i]), (PG8_LAS unsigned*)(lds + (bufoff) + ldsw + _i * 8192), 16, 0, 0); } while (0)
#define PG8_LDA(dst, b, h) do { _Pragma("unroll") for (int m = 0; m < 4; ++m) _Pragma("unroll") for (int k = 0; k < 2; ++k) dst[m][k] = *(const PG8_LAS bf16x8*)(lds + PG8_SA(b, h) + aoff + m * 2048 + k * 1024); } while (0)
#define PG8_LDB(dst, b, h) do { _Pragma("unroll") for (int n = 0; n < 2; ++n) _Pragma("unroll") for (int k = 0; k < 2; ++k) dst[n][k] = *(const PG8_LAS bf16x8*)(lds + PG8_SB(b, h) + boff + n * 2048 + k * 1024); } while (0)
#define PG8_MMA(ai, bj, At, Bt) do { __builtin_amdgcn_s_setprio(1); _Pragma("unroll") for (int m = 0; m < 4; ++m) _Pragma("unroll") for (int n = 0; n < 2; ++n) _Pragma("unroll") for (int k = 0; k < 2; ++k) \
        acc[ai][bj][m][n] = __builtin_amdgcn_mfma_f32_16x16x32_bf16(Bt[n][k], At[m][k], acc[ai][bj][m][n], 0, 0, 0); __builtin_amdgcn_s_setprio(0); } while (0)
#define PG8_WAIT_V(n) asm volatile("s_waitcnt vmcnt(" #n ")" ::: "memory")
#define PG8_WAIT_L(n) asm volatile("s_waitcnt lgkmcnt(" #n ")" ::: "memory")
#define PG8_BAR __builtin_amdgcn_s_barrier()
#define PG8_SCHED __builtin_amdgcn_sched_barrier(0)
    Unit cur, nxt; int ui = 0;
    if (!S.next(0, cur)) return;
    f32x4 acc[2][2][4][2];
#pragma unroll
    for (int a = 0; a < 2; ++a)
#pragma unroll
        for (int b = 0; b < 2; ++b)
#pragma unroll
            for (int m = 0; m < 4; ++m)
#pragma unroll
                for (int n = 0; n < 2; ++n) acc[a][b][m][n] = (f32x4){0.f, 0.f, 0.f, 0.f};
    bf16x8 At[4][2], B0[2][2], B1[2][2];
    const char* cA = (const char*)g.A + (size_t)cur.pm * tstep; const char* cB = (const char*)g.Bt + (size_t)cur.pn * tstep;
    S.a_ready(cur);
    PG8_STAGE(PG8_SB(0, 0), cB, voffB); PG8_STAGE(PG8_SA(0, 0), cA, voffA); PG8_STAGE(PG8_SB(0, 1), cB + hstep, voffB); PG8_STAGE(PG8_SA(0, 1), cA + hstep, voffA);
    if (wr == 1) PG8_BAR;
    PG8_WAIT_V(4); PG8_BAR;
    PG8_STAGE(PG8_SB(1, 0), cB + kstep, voffB); PG8_STAGE(PG8_SA(1, 0), cA + kstep, voffA); PG8_STAGE(PG8_SB(1, 1), cB + hstep + kstep, voffB);
    PG8_WAIT_V(6); PG8_BAR;
    PG8_STAMP();
    for (;;) {
        const bool has_next = S.next(ui + 1, nxt);
        const char* nA = has_next ? (const char*)g.A + (size_t)nxt.pm * tstep : cA; const char* nB = has_next ? (const char*)g.Bt + (size_t)nxt.pn * tstep : cB;
        for (int t = 0; t < nt; t += 2) {
            const bool last = (t == nt - 2);
            const char* a1 = cA + (size_t)(t + 1) * kstep;
            const char* a2 = last ? nA : cA + (size_t)(t + 2) * kstep; const char* b2 = last ? nB : cB + (size_t)(t + 2) * kstep;
            const char* a3 = a2 + kstep; const char* b3 = b2 + kstep;
            if (last && has_next) S.a_ready(nxt);
            PG8_LDB(B0, 0, 0); PG8_SCHED; PG8_LDA(At, 0, 0); PG8_STAGE(PG8_SA(1, 1), a1 + hstep, voffA);
            PG8_WAIT_L(8); PG8_BAR; PG8_WAIT_L(0); PG8_MMA(0, 0, At, B0); PG8_BAR; PG8_SCHED;
            PG8_LDB(B1, 0, 1); PG8_STAGE(PG8_SB(0, 0), b2, voffB);
            PG8_BAR; PG8_WAIT_L(0); PG8_MMA(0, 1, At, B1); PG8_BAR;
            PG8_LDA(At, 0, 1); PG8_STAGE(PG8_SA(0, 0), a2, voffA);
            PG8_BAR; PG8_WAIT_L(0); PG8_MMA(1, 0, At, B0); PG8_BAR; PG8_SCHED;
            PG8_STAGE(PG8_SB(0, 1), b2 + hstep, voffB);
            PG8_WAIT_V(6); PG8_BAR; PG8_MMA(1, 1, At, B1); PG8_BAR;
            PG8_LDB(B0, 1, 0); PG8_SCHED; PG8_LDA(At, 1, 0); PG8_STAGE(PG8_SA(0, 1), a2 + hstep, voffA);
            PG8_WAIT_L(8); PG8_BAR; PG8_WAIT_L(0); PG8_MMA(0, 0, At, B0); PG8_BAR; PG8_SCHED;
            PG8_LDB(B1, 1, 1); PG8_STAGE(PG8_SB(1, 0), b3, voffB);
            PG8_BAR; PG8_WAIT_L(0); PG8_MMA(0, 1, At, B1); PG8_BAR;
            PG8_LDA(At, 1, 1); PG8_STAGE(PG8_SA(1, 0), a3, voffA);
            PG8_BAR; PG8_WAIT_L(0); PG8_MMA(1, 0, At, B0); PG8_BAR; PG8_SCHED;
            PG8_STAGE(PG8_SB(1, 1), b3 + hstep, voffB);
            PG8_WAIT_V(6); PG8_BAR; PG8_MMA(1, 1, At, B1); PG8_BAR;
        }
        PG8_STAMP();
        if constexpr (!Epi::AFTER_DRAIN) { E(acc, cur, wr, wc, fr, fq); S.done(cur); }
        PG8_STAMP();
        if (!has_next) break;
#pragma unroll
        for (int a = 0; a < 2; ++a)
#pragma unroll
            for (int b = 0; b < 2; ++b)
#pragma unroll
                for (int m = 0; m < 4; ++m)
#pragma unroll
                    for (int n = 0; n < 2; ++n) acc[a][b][m][n] = (f32x4){0.f, 0.f, 0.f, 0.f};
        cur = nxt; cA = nA; cB = nB; ++ui;
    }
    PG8_WAIT_V(0);
    if (wr == 0) PG8_BAR;
    PG8_BAR;
    if constexpr (Epi::AFTER_DRAIN) { E.fused(acc, cur, wr, wc, fr, fq, lds, wid, lane); S.done(cur); }
    PG8_STAMP();
    if (STAMP && wid == 0) { stamps[lane] = lane < nts ? (((unsigned long long)(unsigned)ts_hi << 32) | (unsigned)ts_lo) : 0ull;
        if (lane == 62) stamps[62] = rt_entry; if (lane == 63) stamps[63] = (unsigned long long)wall_clock64(); }
#undef PG8_STAMP
#undef PG8_SA
#undef PG8_SB
#undef PG8_STAGE
#undef PG8_LDA
#undef PG8_LDB
#undef PG8_MMA
#undef PG8_WAIT_V
#undef PG8_WAIT_L
#undef PG8_BAR
#undef PG8_SCHED
}
}
using pg8::bf16_t; using pg8::bf16x8; using pg8::f32x4; using pg8::cvt_pk_bf16;
#define LAS __attribute__((address_space(3)))
typedef unsigned u32x2v __attribute__((ext_vector_type(2)));
typedef unsigned u32x4v __attribute__((ext_vector_type(4)));

constexpr int NTOK = 81920, NPR = 65536;
constexpr int LDS_BYTES = 147456;
constexpr float RMS_EPS = 1e-6f;

constexpr size_t OFF_WIN = 0, OFF_WG = OFF_WIN + 5120ull * 1024 * 2, OFF_WA = OFF_WG + 8ull * 512 * 128 * 2, OFF_WB = OFF_WA + 1024ull * 1024 * 2,
    OFF_WO = OFF_WB + 1024ull * 512 * 2, OFF_WUP = OFF_WO + 1024ull * 1024 * 2, OFF_WD = OFF_WUP + 5632ull * 1024 * 2, OFF_DA1 = OFF_WD + 1024ull * 2816 * 2,
    OFF_DA3S = OFF_DA1 + 128 * 128 * 2, OFF_DA3L = OFF_DA3S + 64 * 128 * 2, OFF_TW4 = OFF_DA3L + 128 * 256 * 2, OFF_TW8 = OFF_TW4 + 4096 * 8, OFF_MOD = OFF_TW8 + 8192 * 8,
    OFF_ST1 = OFF_MOD + 18 * 6144 * 4, OFF_ST2 = OFF_ST1 + NTOK * 4, OFF_AGG = OFF_ST2 + NTOK * 4, OFF_CAR = OFF_AGG + 640ull * 2 * 1024 * 8, OFF_LC = OFF_CAR + 640ull * 2 * 1024 * 4, OFF_BAR = OFF_LC + 2048 * 16, OFF_SMALL_END = OFF_BAR + 16384;
constexpr size_t OFF_BIG = 67108864ull, REG_BYTES = (size_t)NTOK * 1024 * 2;
static_assert(OFF_SMALL_END <= OFF_BIG, "small region overflow");
#define REG(i) (OFF_BIG + (size_t)(i) * REG_BYTES)

struct Params {
    const float *x_prompt, *x_sample, *c_prompt, *c_sample, *w_ada, *b_ada, *g_pre_mix, *w_in, *conv_w, *conv_b, *w_lru_a, *b_lru_a, *w_lru_x, *b_lru_x, *lru_lambda,
        *w_a_out, *w_b_out, *w_o, *g_post_mix, *g_pre_ffn, *w_up, *ffn_conv_w, *ffn_conv_b, *w_down, *g_post_ffn;
    float* out; unsigned char* ws; int ph_lo, ph_hi;
};

__device__ __forceinline__ float bf2f(unsigned v) { return __uint_as_float(v << 16); }
__device__ __forceinline__ float bflo(unsigned v) { return __uint_as_float(v << 16); }
__device__ __forceinline__ float bfhi(unsigned v) { return __uint_as_float(v & 0xffff0000u); }
__device__ __forceinline__ bf16_t f2bf(float f) { unsigned u = __float_as_uint(f); u += 0x7FFFu + ((u >> 16) & 1u); return (bf16_t)(u >> 16); }
__device__ __forceinline__ float sigm(float x) { return __builtin_amdgcn_rcpf(1.0f + __expf(-x)); }
__device__ __forceinline__ float gelu_t(float x) { const float u = x * __builtin_fmaf(x * x, -0.10294324f, -2.3022082f); return x * __builtin_amdgcn_rcpf(1.0f + __builtin_amdgcn_exp2f(u)); }
__device__ __forceinline__ float wave_sum(float v) {
#pragma unroll
    for (int o = 32; o >= 1; o >>= 1) v += __shfl_xor(v, o);
    return v;
}
__device__ __forceinline__ int seq_of_tok(int tok) { return tok < NPR ? (tok >> 12) : 16 + ((tok - NPR) >> 13); }
__device__ __forceinline__ const float* xrow(const Params& p, int tok) { return tok < NPR ? p.x_prompt + (size_t)tok * 1024 : p.x_sample + (size_t)(tok - NPR) * 1024; }

__device__ __forceinline__ int klog_of(int pp) { return 32 * (pp >> 5) + (pp & 3) + 4 * ((pp >> 3) & 3) + 16 * ((pp >> 2) & 1); }

__device__ __forceinline__ void transpose_tile(const float* __restrict__ src, int ld, int sc0, int k0, bf16_t* __restrict__ dst, int K, int dr0, LAS float* tile) {
    const int t = threadIdx.x;
    {
        const int r = t >> 4, c4 = t & 15;
#pragma unroll
        for (int i = 0; i < 2; ++i) {
            const float4 v = *(const float4*)(src + (size_t)(k0 + r + 32 * i) * ld + sc0 + 4 * c4);
            LAS float* d = tile + (r + 32 * i) * 65 + 4 * c4; d[0] = v.x; d[1] = v.y; d[2] = v.z; d[3] = v.w;
        }
    }
    __syncthreads();
    {
        const int n = t >> 3, kc = t & 7; float f[8];
#pragma unroll
        for (int j = 0; j < 8; ++j) f[j] = tile[(8 * kc + j) * 65 + n];
        u32x4v o; o.x = cvt_pk_bf16(f[0], f[1]); o.y = cvt_pk_bf16(f[2], f[3]); o.z = cvt_pk_bf16(f[4], f[5]); o.w = cvt_pk_bf16(f[6], f[7]);
        *(u32x4v*)(dst + (size_t)(dr0 + n) * K + k0 + 8 * kc) = o;
    }
    __syncthreads();
}

__device__ __forceinline__ void prep_phase(const Params& p, LAS unsigned char* lds) {
    const int tid = threadIdx.x;
    unsigned char* ws = p.ws;
    bf16_t* WinT = (bf16_t*)(ws + OFF_WIN);
    {
        const int gtid = blockIdx.x * 512 + tid, gsz = gridDim.x * 512;
        bf16_t* A1 = (bf16_t*)(ws + OFF_DA1); bf16_t* A3S = (bf16_t*)(ws + OFF_DA3S); bf16_t* A3L = (bf16_t*)(ws + OFF_DA3L);
        for (int i = gtid; i < 128 * 128; i += gsz) {
            const int row = i >> 7, pp = i & 127, kl = klog_of(pp), k1 = row >> 1, po = row & 1, pin = kl >> 6, s1 = kl & 63;
            float s, c; sincospif((float)((k1 * s1) & 63) * (1.0f / 32.0f), &s, &c);
            const float v = po == 0 ? (pin == 0 ? c : s) : (pin == 0 ? -s : c);
            A1[i] = f2bf(v);
        }
        for (int i = gtid; i < 64 * 128; i += gsz) {
            const int k2 = i >> 7, pp = i & 127, kl = klog_of(pp), pin = kl >> 6, s2 = kl & 63;
            float s, c; sincospif((float)((k2 * s2) & 63) * (1.0f / 32.0f), &s, &c);
            A3S[i] = f2bf(pin == 0 ? c : s);
        }
        for (int i = gtid; i < 128 * 256; i += gsz) {
            const int k2 = i >> 8, pp = i & 255, kl = klog_of(pp), pin = kl >> 7, s2 = kl & 127;
            float s, c; sincospif((float)((k2 * s2) & 127) * (1.0f / 64.0f), &s, &c);
            A3L[i] = f2bf(pin == 0 ? c : s);
        }
        float2* tw4 = (float2*)(ws + OFF_TW4); float2* tw8 = (float2*)(ws + OFF_TW8);
        for (int i = gtid; i < 4096; i += gsz) { float s, c; sincospif((float)i * (1.0f / 2048.0f), &s, &c); tw4[i] = make_float2(c, s); }
        for (int i = gtid; i < 8192; i += gsz) { float s, c; sincospif((float)i * (1.0f / 4096.0f), &s, &c); tw8[i] = make_float2(c, s); }
        float* st = (float*)(ws + OFF_ST1);
        for (int i = gtid; i < 2 * NTOK; i += gsz) st[i] = 0.f;
        float4* lc = (float4*)(ws + OFF_LC);
        for (int i = gtid; i < 2048; i += gsz) lc[i] = make_float4(8.0f * 1.4426950408889634f * log1pf(__expf(-p.lru_lambda[i])), -1.4426950408889634f * p.b_lru_a[i], -1.4426950408889634f * p.b_lru_x[i], 0.f);
    }
    constexpr int N_MOD = 96, N_Z = 64, N_TR = 3904;
    for (int it = blockIdx.x; it < N_MOD + N_Z + N_TR; it += gridDim.x) {
        if (it < N_MOD) {
            LAS float* sc = (LAS float*)lds;
            LAS float* red = (LAS float*)(lds + 73728);
            for (int i = tid; i < 18 * 1024; i += 512) { const int b = i >> 10, k = i & 1023; const float c = b < 16 ? p.c_prompt[b * 1024 + k] : p.c_sample[(b - 16) * 1024 + k]; sc[i] = c * sigm(c); }
            __syncthreads();
            const int col = tid & 63, kg = tid >> 6, n0 = it * 64;
            float acc[18];
#pragma unroll
            for (int b = 0; b < 18; ++b) acc[b] = 0.f;
#pragma unroll 4
            for (int i = 0; i < 128; ++i) {
                const int k = kg * 128 + i; const float w = p.w_ada[(size_t)k * 6144 + n0 + col];
#pragma unroll
                for (int b = 0; b < 18; ++b) acc[b] += sc[b * 1024 + k] * w;
            }
#pragma unroll
            for (int b = 0; b < 18; ++b) red[(kg * 18 + b) * 64 + col] = acc[b];
            __syncthreads();
            float* mod = (float*)(ws + OFF_MOD);
            for (int i = tid; i < 18 * 64; i += 512) { const int b = i >> 6, c = i & 63; float s = p.b_ada[n0 + c];
#pragma unroll
                for (int g = 0; g < 8; ++g) s += red[(g * 18 + b) * 64 + c];
                mod[b * 6144 + n0 + c] = s; }
            __syncthreads();
        } else if (it < N_MOD + N_Z) {
            const int zi = it - N_MOD, g = zi >> 4, k0 = (zi & 15) * 64;
            LAS float* wt = (LAS float*)lds;
            LAS float* tc = (LAS float*)(lds + 64 * 129 * 4); LAS float* tsn = tc + 128;
#pragma unroll
            for (int i = 0; i < 4; ++i) { const int idx = tid + 512 * i, r = idx >> 5, c4 = idx & 31;
                const float4 v = *(const float4*)(p.w_in + (size_t)(k0 + r) * 4608 + 2048 + g * 128 + 4 * c4);
                LAS float* d = wt + r * 129 + 4 * c4; d[0] = v.x; d[1] = v.y; d[2] = v.z; d[3] = v.w; }
            if (tid < 128) { float s, c; sincospif((float)tid * (1.0f / 64.0f), &s, &c); tc[tid] = c; tsn[tid] = s; }
            __syncthreads();
            const int kin = tid & 63, mg = tid >> 6;
            for (int mi = 0; mi < 12; ++mi) { const int m = mg * 12 + mi; float aC = 0.f, aS = 0.f;
                if (m <= 64) {
#pragma unroll 8
                    for (int c = 0; c < 128; ++c) { const float w = wt[kin * 129 + c]; const int q = (m * c) & 127; aC += w * tc[q]; aS += w * tsn[q]; } }
                WinT[(size_t)(2048 + g * 96 + m) * 1024 + k0 + kin] = f2bf(aC);
                WinT[(size_t)(2048 + 384 + g * 96 + m) * 1024 + k0 + kin] = f2bf(-aS); }
            __syncthreads();
        } else {
            int j = it - N_MOD - N_Z; LAS float* tile = (LAS float*)lds;
            if (j < 512) { const int kt = j & 15, nt = j >> 4; transpose_tile(p.w_in, 4608, nt * 64, kt * 64, WinT, 1024, nt * 64, tile); continue; } j -= 512;
            if (j < 512) { const int kt = j & 15, nt = j >> 4; transpose_tile(p.w_in, 4608, 2560 + nt * 64, kt * 64, WinT, 1024, 2816 + nt * 64, tile); continue; } j -= 512;
            if (j < 256) { const int kt = j & 15, nt = j >> 4; transpose_tile(p.w_a_out, 1024, nt * 64, kt * 64, (bf16_t*)(ws + OFF_WA), 1024, nt * 64, tile); continue; } j -= 256;
            if (j < 128) { const int kt = j & 7, nt = j >> 3; transpose_tile(p.w_b_out, 1024, nt * 64, kt * 64, (bf16_t*)(ws + OFF_WB), 512, nt * 64, tile); continue; } j -= 128;
            if (j < 256) { const int kt = j & 15, nt = j >> 4; transpose_tile(p.w_o, 1024, nt * 64, kt * 64, (bf16_t*)(ws + OFF_WO), 1024, nt * 64, tile); continue; } j -= 256;
            if (j < 1408) { const int kt = j & 15, nt = j >> 4, t256 = nt >> 2, sub = nt & 3, half = sub >> 1, jj0 = (sub & 1) * 64;
                transpose_tile(p.w_up, 5632, half * 2816 + 128 * t256 + jj0, kt * 64, (bf16_t*)(ws + OFF_WUP), 1024, nt * 64, tile); continue; } j -= 1408;
            if (j < 704) { const int kt = j % 44, nt = j / 44; transpose_tile(p.w_down, 1024, nt * 64, kt * 64, (bf16_t*)(ws + OFF_WD), 2816, nt * 64, tile); continue; } j -= 704;
            { const int mat = j >> 2, kt = j & 1, nt = (j >> 1) & 1, hd = mat & 7, which = (mat >> 3) & 1, dir = mat >> 4;
              const float* src = (which ? p.w_lru_x : p.w_lru_a) + (size_t)(dir * 8 + hd) * 128 * 128;
              transpose_tile(src, 128, nt * 64, kt * 64, (bf16_t*)(ws + OFF_WG), 128, hd * 512 + (dir * 2 + which) * 128 + nt * 64, tile); }
        }
    }
}

__device__ __forceinline__ void h1_phase(const Params& p) {
    const int lane = threadIdx.x & 63, w = threadIdx.x >> 6;
    const float* mod = (const float*)(p.ws + OFF_MOD); bf16_t* h1 = (bf16_t*)p.out;
    for (int row0 = (blockIdx.x * 8 + w) * 2; row0 < NTOK; row0 += gridDim.x * 16) {
        float4 v[2][4]; float ss[2];
#pragma unroll
        for (int r = 0; r < 2; ++r) { const float* x = xrow(p, row0 + r);
#pragma unroll
            for (int i = 0; i < 4; ++i) v[r][i] = *(const float4*)(x + 4 * (lane + 64 * i)); }
#pragma unroll
        for (int r = 0; r < 2; ++r) { float s = 0.f;
#pragma unroll
            for (int i = 0; i < 4; ++i) s += v[r][i].x * v[r][i].x + v[r][i].y * v[r][i].y + v[r][i].z * v[r][i].z + v[r][i].w * v[r][i].w;
            ss[r] = s; }
#pragma unroll
        for (int o = 32; o >= 1; o >>= 1) { ss[0] += __shfl_xor(ss[0], o); ss[1] += __shfl_xor(ss[1], o); }
        const float* md = mod + seq_of_tok(row0) * 6144;
#pragma unroll
        for (int r = 0; r < 2; ++r) { const float rs = rsqrtf(ss[r] * (1.0f / 1024.0f) + RMS_EPS);
#pragma unroll
            for (int i = 0; i < 4; ++i) { const int c = 4 * (lane + 64 * i);
                const float4 g = *(const float4*)(p.g_pre_mix + c), sh = *(const float4*)(md + c), sc = *(const float4*)(md + 1024 + c);
                u32x2v o; o.x = cvt_pk_bf16(v[r][i].x * rs * g.x * (1.f + sc.x) + sh.x, v[r][i].y * rs * g.y * (1.f + sc.y) + sh.y);
                o.y = cvt_pk_bf16(v[r][i].z * rs * g.z * (1.f + sc.z) + sh.z, v[r][i].w * rs * g.w * (1.f + sc.w) + sh.w);
                *(u32x2v*)(h1 + (size_t)(row0 + r) * 1024 + c) = o; } }
    }
}
__device__ __forceinline__ void x1_phase(const Params& p) {
    const int lane = threadIdx.x & 63, w = threadIdx.x >> 6;
    const float* mod = (const float*)(p.ws + OFF_MOD); const float* st1 = (const float*)(p.ws + OFF_ST1);
    const bf16_t* mo = (const bf16_t*)(p.ws + REG(2)); bf16_t* h2 = (bf16_t*)(p.ws + REG(0));
    for (int row0 = (blockIdx.x * 8 + w) * 2; row0 < NTOK; row0 += gridDim.x * 16) {
        float4 v[2][4]; u32x2v m[2][4]; float ss[2];
#pragma unroll
        for (int r = 0; r < 2; ++r) { const float* x = xrow(p, row0 + r);
#pragma unroll
            for (int i = 0; i < 4; ++i) { const int c = 4 * (lane + 64 * i); v[r][i] = *(const float4*)(x + c); m[r][i] = *(const u32x2v*)(mo + (size_t)(row0 + r) * 1024 + c); } }
        const float* md = mod + seq_of_tok(row0) * 6144;
#pragma unroll
        for (int r = 0; r < 2; ++r) { const float rs1 = rsqrtf(st1[row0 + r] * (1.0f / 1024.0f) + RMS_EPS); float s = 0.f;
#pragma unroll
            for (int i = 0; i < 4; ++i) { const int c = 4 * (lane + 64 * i); const float4 g = *(const float4*)(p.g_post_mix + c), gt = *(const float4*)(md + 2048 + c);
                v[r][i].x += gt.x * g.x * rs1 * bflo(m[r][i].x); v[r][i].y += gt.y * g.y * rs1 * bfhi(m[r][i].x); v[r][i].z += gt.z * g.z * rs1 * bflo(m[r][i].y); v[r][i].w += gt.w * g.w * rs1 * bfhi(m[r][i].y);
                *(float4*)(p.out + (size_t)(row0 + r) * 1024 + c) = v[r][i];
                s += v[r][i].x * v[r][i].x + v[r][i].y * v[r][i].y + v[r][i].z * v[r][i].z + v[r][i].w * v[r][i].w; }
            ss[r] = s; }
#pragma unroll
        for (int o = 32; o >= 1; o >>= 1) { ss[0] += __shfl_xor(ss[0], o); ss[1] += __shfl_xor(ss[1], o); }
#pragma unroll
        for (int r = 0; r < 2; ++r) { const float rs = rsqrtf(ss[r] * (1.0f / 1024.0f) + RMS_EPS);
#pragma unroll
            for (int i = 0; i < 4; ++i) { const int c = 4 * (lane + 64 * i);
                const float4 g = *(const float4*)(p.g_pre_ffn + c), sh = *(const float4*)(md + 3072 + c), sc = *(const float4*)(md + 4096 + c);
                u32x2v o; o.x = cvt_pk_bf16(v[r][i].x * rs * g.x * (1.f + sc.x) + sh.x, v[r][i].y * rs * g.y * (1.f + sc.y) + sh.y);
                o.y = cvt_pk_bf16(v[r][i].z * rs * g.z * (1.f + sc.z) + sh.z, v[r][i].w * rs * g.w * (1.f + sc.w) + sh.w);
                *(u32x2v*)(h2 + (size_t)(row0 + r) * 1024 + c) = o; } }
    }
}
__device__ __forceinline__ void final_phase(const Params& p) {
    const int lane = threadIdx.x & 63, w = threadIdx.x >> 6;
    const float* mod = (const float*)(p.ws + OFF_MOD); const float* st2 = (const float*)(p.ws + OFF_ST2);
    const bf16_t* f = (const bf16_t*)(p.ws + REG(1));
    for (int row0 = (blockIdx.x * 8 + w) * 2; row0 < NTOK; row0 += gridDim.x * 16) {
        float4 v[2][4]; u32x2v m[2][4];
#pragma unroll
        for (int r = 0; r < 2; ++r)
#pragma unroll
            for (int i = 0; i < 4; ++i) { const int c = 4 * (lane + 64 * i); v[r][i] = *(const float4*)(p.out + (size_t)(row0 + r) * 1024 + c); m[r][i] = *(const u32x2v*)(f + (size_t)(row0 + r) * 1024 + c); }
        const float* md = mod + seq_of_tok(row0) * 6144;
#pragma unroll
        for (int r = 0; r < 2; ++r) { const float rs = rsqrtf(st2[row0 + r] * (1.0f / 1024.0f) + RMS_EPS);
#pragma unroll
            for (int i = 0; i < 4; ++i) { const int c = 4 * (lane + 64 * i); const float4 g = *(const float4*)(p.g_post_ffn + c), gt = *(const float4*)(md + 5120 + c); float4 o = v[r][i];
                o.x += gt.x * g.x * rs * bflo(m[r][i].x); o.y += gt.y * g.y * rs * bfhi(m[r][i].x); o.z += gt.z * g.z * rs * bflo(m[r][i].y); o.w += gt.w * g.w * rs * bfhi(m[r][i].y);
                *(float4*)(p.out + (size_t)(row0 + r) * 1024 + c) = o; } }
    }
}

#define EPI_LOOP_ROWS for (int ai = 0; ai < 2; ++ai) _Pragma("unroll") for (int m = 0; m < 4; ++m)
__device__ __forceinline__ u32x4v pack8(const f32x4 a, const f32x4 b) { u32x4v o; o.x = cvt_pk_bf16(a[0], a[1]); o.y = cvt_pk_bf16(a[2], a[3]); o.z = cvt_pk_bf16(b[0], b[1]); o.w = cvt_pk_bf16(b[2], b[3]); return o; }

struct EpiIn {
    static constexpr bool PERM = true, AFTER_DRAIN = false; unsigned char* ws;
    __device__ __forceinline__ void operator()(const f32x4 (&acc)[2][2][4][2], const pg8::Unit& u, int wr, int wc, int fr, int fq) const {
        const int pn = u.pn, tok0 = u.pm * 256; bf16_t* tb[2]; int ld;
        if (pn < 4) { tb[0] = (bf16_t*)(ws + REG(0)) + (size_t)tok0 * 1024 + pn * 256; tb[1] = tb[0] + 128; ld = 1024; }
        else if (pn < 8) { tb[0] = (bf16_t*)(ws + REG(1)) + (size_t)tok0 * 1024 + (pn - 4) * 256; tb[1] = tb[0] + 128; ld = 1024; }
        else if (pn < 11) { int S, s0; if (tok0 < NPR) { S = 4096; s0 = tok0 & 4095; } else { S = 8192; s0 = (tok0 - NPR) & 8191; }
            bf16_t* zb = (bf16_t*)(ws + REG(4)) + (size_t)(tok0 - s0) * 1024 + (size_t)s0 * 384; ld = 384;
#pragma unroll
            for (int bj = 0; bj < 2; ++bj) { const int zc = (pn - 8) * 256 + bj * 128, plane = zc >= 384 ? 1 : 0; tb[bj] = zb + (size_t)plane * S * 384 + (zc - plane * 384); } }
        else if (pn < 15) { tb[0] = (bf16_t*)(ws + REG(2)) + (size_t)tok0 * 1024 + (pn - 11) * 256; tb[1] = tb[0] + 128; ld = 1024; }
        else { tb[0] = (bf16_t*)(ws + REG(3)) + (size_t)tok0 * 1024 + (pn - 15) * 256; tb[1] = tb[0] + 128; ld = 1024; }
        const size_t lo = (size_t)(wr * 64 + fr) * ld + wc * 32 + 8 * fq;
#pragma unroll
        EPI_LOOP_ROWS { const size_t ro = lo + (size_t)(ai * 128 + m * 16) * ld;
#pragma unroll
            for (int bj = 0; bj < 2; ++bj) *(u32x4v*)(tb[bj] + ro) = pack8(acc[ai][bj][m][0], acc[ai][bj][m][1]); }
    }
};
struct EpiUp {
    static constexpr bool PERM = true, AFTER_DRAIN = false; bf16_t* O; int ld;
    __device__ __forceinline__ void operator()(const f32x4 (&acc)[2][2][4][2], const pg8::Unit& u, int wr, int wc, int fr, int fq) const {
        bf16_t* tb = O + (size_t)(u.pm * 256 + wr * 64 + fr) * ld + u.pn * 256 + wc * 32 + 8 * fq;
#pragma unroll
        EPI_LOOP_ROWS { bf16_t* rp = tb + (size_t)(ai * 128 + m * 16) * ld;
#pragma unroll
            for (int bj = 0; bj < 2; ++bj) *(u32x4v*)(rp + bj * 128) = pack8(acc[ai][bj][m][0], acc[ai][bj][m][1]); }
    }
};
struct EpiGateA {
    static constexpr bool PERM = true, AFTER_DRAIN = false; const bf16_t* G; bf16_t* T;
    __device__ __forceinline__ void operator()(const f32x4 (&acc)[2][2][4][2], const pg8::Unit& u, int wr, int wc, int fr, int fq) const {
        const size_t off0 = (size_t)(u.pm * 256 + wr * 64 + fr) * 1024 + u.pn * 256 + wc * 32 + 8 * fq;
        u32x4v gv[2][2][2];
#define GA_LOAD(QI) { _Pragma("unroll") for (int mm = 0; mm < 2; ++mm) _Pragma("unroll") for (int bj = 0; bj < 2; ++bj) \
            gv[(QI) & 1][mm][bj] = *(const u32x4v*)(G + off0 + (size_t)(((QI) >> 1) * 128 + (((QI) & 1) * 2 + mm) * 16) * 1024 + bj * 128); }
        GA_LOAD(0)
#pragma unroll
        for (int qi = 0; qi < 4; ++qi) { const int ai = qi >> 1;
            if (qi < 3) GA_LOAD(qi + 1)
            __builtin_amdgcn_sched_barrier(0);
#pragma unroll
            for (int mm = 0; mm < 2; ++mm)
#pragma unroll
                for (int bj = 0; bj < 2; ++bj) { const int m = (qi & 1) * 2 + mm; const size_t off = off0 + (size_t)(ai * 128 + m * 16) * 1024 + bj * 128; const u32x4v g = gv[qi & 1][mm][bj];
                    f32x4 a = acc[ai][bj][m][0], b = acc[ai][bj][m][1];
                    a[0] *= sigm(bflo(g.x)); a[1] *= sigm(bfhi(g.x)); a[2] *= sigm(bflo(g.y)); a[3] *= sigm(bfhi(g.y));
                    b[0] *= sigm(bflo(g.z)); b[1] *= sigm(bfhi(g.z)); b[2] *= sigm(bflo(g.w)); b[3] *= sigm(bfhi(g.w));
                    *(u32x4v*)(T + off) = pack8(a, b); }
            __builtin_amdgcn_sched_barrier(0); }
#undef GA_LOAD
    }
};
struct EpiGateB {
    static constexpr bool PERM = true, AFTER_DRAIN = false; const bf16_t* G; bf16_t* T;
    __device__ __forceinline__ void operator()(const f32x4 (&acc)[2][2][4][2], const pg8::Unit& u, int wr, int wc, int fr, int fq) const {
        const size_t off0 = (size_t)(u.pm * 256 + wr * 64 + fr) * 1024 + u.pn * 256 + wc * 32 + 8 * fq;
        u32x4v gv[2][2][2], tv[2][2][2];
#define GB_LOAD(QI) { _Pragma("unroll") for (int mm = 0; mm < 2; ++mm) _Pragma("unroll") for (int bj = 0; bj < 2; ++bj) { \
            const size_t o_ = off0 + (size_t)(((QI) >> 1) * 128 + (((QI) & 1) * 2 + mm) * 16) * 1024 + bj * 128; gv[(QI) & 1][mm][bj] = *(const u32x4v*)(G + o_); tv[(QI) & 1][mm][bj] = *(const u32x4v*)(T + o_); } }
        GB_LOAD(0)
#pragma unroll
        for (int qi = 0; qi < 4; ++qi) { const int ai = qi >> 1;
            if (qi < 3) GB_LOAD(qi + 1)
            __builtin_amdgcn_sched_barrier(0);
#pragma unroll
            for (int mm = 0; mm < 2; ++mm)
#pragma unroll
                for (int bj = 0; bj < 2; ++bj) { const int m = (qi & 1) * 2 + mm; const size_t off = off0 + (size_t)(ai * 128 + m * 16) * 1024 + bj * 128; const u32x4v g = gv[qi & 1][mm][bj], t = tv[qi & 1][mm][bj];
                    f32x4 a = acc[ai][bj][m][0], b = acc[ai][bj][m][1];
                    a[0] = bflo(t.x) + a[0] * sigm(bflo(g.x)); a[1] = bfhi(t.x) + a[1] * sigm(bfhi(g.x)); a[2] = bflo(t.y) + a[2] * sigm(bflo(g.y)); a[3] = bfhi(t.y) + a[3] * sigm(bfhi(g.y));
                    b[0] = bflo(t.z) + b[0] * sigm(bflo(g.z)); b[1] = bfhi(t.z) + b[1] * sigm(bfhi(g.z)); b[2] = bflo(t.w) + b[2] * sigm(bflo(g.w)); b[3] = bfhi(t.w) + b[3] * sigm(bfhi(g.w));
                    *(u32x4v*)(T + off) = pack8(a, b); }
            __builtin_amdgcn_sched_barrier(0); }
#undef GB_LOAD
    }
};
struct EpiStat {
    static constexpr bool PERM = true, AFTER_DRAIN = false; bf16_t* O; float* stat;
    __device__ __forceinline__ void operator()(const f32x4 (&acc)[2][2][4][2], const pg8::Unit& u, int wr, int wc, int fr, int fq) const {
        const int row0 = u.pm * 256 + wr * 64 + fr; const size_t off0 = (size_t)row0 * 1024 + u.pn * 256 + wc * 32 + 8 * fq;
#pragma unroll
        EPI_LOOP_ROWS { float ss = 0.f;
#pragma unroll
            for (int bj = 0; bj < 2; ++bj) { const size_t off = off0 + (size_t)(ai * 128 + m * 16) * 1024 + bj * 128; const f32x4 a = acc[ai][bj][m][0], b = acc[ai][bj][m][1];
                ss += a[0] * a[0] + a[1] * a[1] + a[2] * a[2] + a[3] * a[3] + b[0] * b[0] + b[1] * b[1] + b[2] * b[2] + b[3] * b[3];
                *(u32x4v*)(O + off) = pack8(a, b); }
            ss += __shfl_xor(ss, 16); ss += __shfl_xor(ss, 32);
            if (fq == 0) atomicAdd(stat + row0 + ai * 128 + m * 16, ss); }
    }
};
struct EpiNull { static constexpr bool PERM = true, AFTER_DRAIN = false; float* sink;
    __device__ __forceinline__ void operator()(const f32x4 (&acc)[2][2][4][2], const pg8::Unit& u, int wr, int wc, int fr, int fq) const {
        float s = 0.f;
#pragma unroll
        for (int ai = 0; ai < 2; ++ai)
#pragma unroll
            for (int bj = 0; bj < 2; ++bj)
#pragma unroll
                for (int m = 0; m < 4; ++m)
#pragma unroll
                    for (int n = 0; n < 2; ++n) s += acc[ai][bj][m][n][0] + acc[ai][bj][m][n][1] + acc[ai][bj][m][n][2] + acc[ai][bj][m][n][3];
        if (s == 12345.678f) *sink = s;
    }
};
struct SameOrder : pg8::StaticOrder { __device__ bool next(int i, pg8::Unit& u) const { const bool r = pg8::StaticOrder::next(i, u); u.pm &= 7; u.pn = 0; return r; } };
template <class Epi> __device__ __forceinline__ void run_gemm_same(LAS unsigned char* lds, const bf16_t* A, const bf16_t* Bt, int M, int N, int K, const Epi& E) {
    pg8::Gemm g; g.A = A; g.Bt = Bt; g.M = M; g.N = N; g.K = K;
    SameOrder S; S.init(M, N, (int)gridDim.x, (int)blockIdx.x);
    pg8::gemm_phase<Epi, SameOrder, false>(lds, g, S, E, nullptr);
}
template <class Epi> __device__ __forceinline__ void run_gemm(LAS unsigned char* lds, const bf16_t* A, const bf16_t* Bt, int M, int N, int K, const Epi& E) {
    pg8::Gemm g; g.A = A; g.Bt = Bt; g.M = M; g.N = N; g.K = K;
    pg8::StaticOrder S; S.init(M, N, (int)gridDim.x, (int)blockIdx.x);
    pg8::gemm_phase<Epi, pg8::StaticOrder, false>(lds, g, S, E, nullptr);
}

__device__ __forceinline__ float bperm(int byte_addr, float v) { return __int_as_float(__builtin_amdgcn_ds_bpermute(byte_addr, __float_as_int(v))); }
__device__ __forceinline__ void lru_scan(f32x4 (&acc)[8][2], int lane, int fq, float& Ptile, float& Htile) {
    const int a1 = ((lane - 16) & 63) << 2, a2 = ((lane - 32) & 63) << 2, aT = ((lane & 15) + 48) << 2;
    const bool f1 = fq >= 1, f2 = fq >= 2;
    float P[8], H[8], Pe[8], He[8], Pt[8], Ht[8];
#pragma unroll
    for (int m = 0; m < 8; ++m) { float p_ = 1.f, h_ = 0.f;
#pragma unroll
        for (int i = 0; i < 4; ++i) { const float a = acc[m][0][i], b = acc[m][1][i]; h_ = a * h_ + b; p_ *= a; }
        P[m] = p_; H[m] = h_; }
#pragma unroll
    for (int m = 0; m < 8; ++m) { const float pq = bperm(a1, P[m]), hq = bperm(a1, H[m]); const float Pp = f1 ? pq : 1.f, Hp = f1 ? hq : 0.f; H[m] = P[m] * Hp + H[m]; P[m] = P[m] * Pp; }
#pragma unroll
    for (int m = 0; m < 8; ++m) { const float pq = bperm(a2, P[m]), hq = bperm(a2, H[m]); const float Pp = f2 ? pq : 1.f, Hp = f2 ? hq : 0.f; H[m] = P[m] * Hp + H[m]; P[m] = P[m] * Pp; }
#pragma unroll
    for (int m = 0; m < 8; ++m) { const float pe = bperm(a1, P[m]), he = bperm(a1, H[m]); Pe[m] = f1 ? pe : 1.f; He[m] = f1 ? he : 0.f; Pt[m] = bperm(aT, P[m]); Ht[m] = bperm(aT, H[m]); }
    float carry = 0.f, pacc = 1.f;
#pragma unroll
    for (int m = 0; m < 8; ++m) { float h = Pe[m] * carry + He[m], pp = Pe[m] * pacc;
#pragma unroll
        for (int i = 0; i < 4; ++i) { const float a = acc[m][0][i]; h = a * h + acc[m][1][i]; pp *= a; acc[m][0][i] = h; acc[m][1][i] = pp; }
        carry = Pt[m] * carry + Ht[m]; pacc *= Pt[m]; }
    Ptile = pacc; Htile = carry;
}

__device__ __forceinline__ bf16_t f2bf_hw(float f) { return (bf16_t)(cvt_pk_bf16(f, 0.f) & 0xffffu); }
__device__ __forceinline__ void lru_phase(const Params& p, LAS unsigned char* lds) {
    int tid_ = threadIdx.x; asm volatile("" : "+v"(tid_));
    const int tid = tid_, lane = tid & 63, w = tid >> 6, fr = lane & 15, fq = lane >> 4;
    const bf16_t* xa = (const bf16_t*)(p.ws + REG(0));
    bf16_t* S0g = (bf16_t*)p.out; bf16_t* Pfg = (bf16_t*)p.out + (size_t)NTOK * 1024; bf16_t* Pbg = (bf16_t*)(p.ws + REG(5));
    const bf16_t* WgT = (const bf16_t*)(p.ws + OFF_WG);
    float2* agg = (float2*)(p.ws + OFF_AGG);
    constexpr int TS = 272;
    LAS unsigned char* raw = lds;
    LAS unsigned char* xc = lds + 34816;
    LAS unsigned char* pl = lds + 69632;
    u32x4v pre0, pre1, pre2, pre3, pre4;
#define LRU_PF1(J, DST) { const int idx_ = tid + (J) * 512, r_ = idx_ >> 4, v_ = idx_ & 15, s_ = pf_s0 - 2 + r_; DST = (u32x4v){0u, 0u, 0u, 0u}; \
        if (idx_ < 131 * 16 && s_ >= 0 && s_ < pf_S) DST = *(const u32x4v*)(xa + (size_t)(pf_tok0 - 2 + r_) * 1024 + pf_hd * 128 + v_ * 8); }
#define LRU_PREFETCH(TILE) { const int pf_hd = (TILE) & 7, pf_tok0 = ((TILE) >> 3) * 128; int pf_S, pf_s0; \
        if (pf_tok0 < NPR) { pf_S = 4096; pf_s0 = pf_tok0 & 4095; } else { pf_S = 8192; pf_s0 = (pf_tok0 - NPR) & 8191; } \
        LRU_PF1(0, pre0) LRU_PF1(1, pre1) LRU_PF1(2, pre2) LRU_PF1(3, pre3) LRU_PF1(4, pre4) }
    if ((int)blockIdx.x < 5120) LRU_PREFETCH((int)blockIdx.x)
    for (int tile = blockIdx.x; tile < 5120; tile += gridDim.x) {
        const int hd = tile & 7, cidx = tile >> 3, tok0 = cidx * 128;
#define LRU_PW1(J, SRC) { const int idx_ = tid + (J) * 512; if (idx_ < 131 * 16) *(LAS u32x4v*)(raw + (idx_ >> 4) * 256 + (idx_ & 15) * 16) = SRC; }
        LRU_PW1(0, pre0) LRU_PW1(1, pre1) LRU_PW1(2, pre2) LRU_PW1(3, pre3) LRU_PW1(4, pre4)
        __syncthreads();
        { typedef float f2 __attribute__((ext_vector_type(2))); const int v = tid & 15; f2 cw[4][4], cb[4];
#pragma unroll
            for (int e = 0; e < 4; ++e) { cb[e] = *(const f2*)(p.conv_b + hd * 128 + v * 8 + 2 * e);
#pragma unroll
                for (int k = 0; k < 4; ++k) cw[k][e] = *(const f2*)(p.conv_w + k * 1024 + hd * 128 + v * 8 + 2 * e); }
#pragma unroll 1
            for (int it = 0; it < 4; ++it) { const int t = (tid >> 4) + it * 32; f2 o[4];
#pragma unroll
                for (int e = 0; e < 4; ++e) o[e] = cb[e];
#pragma unroll
                for (int k = 0; k < 4; ++k) { const u32x4v rv = *(LAS u32x4v*)(raw + (t + k) * 256 + v * 16);
                    o[0] = cw[k][0] * (f2){bflo(rv.x), bfhi(rv.x)} + o[0]; o[1] = cw[k][1] * (f2){bflo(rv.y), bfhi(rv.y)} + o[1];
                    o[2] = cw[k][2] * (f2){bflo(rv.z), bfhi(rv.z)} + o[2]; o[3] = cw[k][3] * (f2){bflo(rv.w), bfhi(rv.w)} + o[3]; }
                u32x4v ov; ov.x = cvt_pk_bf16(o[0].x, o[0].y); ov.y = cvt_pk_bf16(o[1].x, o[1].y); ov.z = cvt_pk_bf16(o[2].x, o[2].y); ov.w = cvt_pk_bf16(o[3].x, o[3].y);
                *(LAS u32x4v*)(xc + t * TS + v * 16) = ov; } }
        __syncthreads();
        if (tile + (int)gridDim.x < 5120) LRU_PREFETCH(tile + (int)gridDim.x)
        const int chl = w * 16 + fr, ch = hd * 128 + chl;
#pragma unroll
        for (int dir = 0; dir < 2; ++dir) {
            const int rsgn = dir ? -1 : 1, rbase = dir ? 127 : 0;
            bf16x8 Bf[2][4];
#pragma unroll
            for (int g = 0; g < 2; ++g)
#pragma unroll
                for (int ks = 0; ks < 4; ++ks) Bf[g][ks] = *(const bf16x8*)(WgT + (size_t)(hd * 512 + (dir * 2 + g) * 128 + chl) * 128 + ks * 32 + fq * 8);
            f32x4 acc[8][2];
#pragma unroll
            for (int m = 0; m < 8; ++m) { acc[m][0] = (f32x4){0.f, 0.f, 0.f, 0.f}; acc[m][1] = (f32x4){0.f, 0.f, 0.f, 0.f}; }
            LAS unsigned char* xa_l = xc + (rbase + rsgn * fr) * TS + fq * 16;
#pragma unroll
            for (int m = 0; m < 8; ++m)
#pragma unroll
                for (int ks = 0; ks < 4; ++ks) { const bf16x8 a = *(LAS bf16x8*)(xa_l + rsgn * (m * 16 * TS) + ks * 64);
                    acc[m][0] = __builtin_amdgcn_mfma_f32_16x16x32_bf16(a, Bf[0][ks], acc[m][0], 0, 0, 0);
                    acc[m][1] = __builtin_amdgcn_mfma_f32_16x16x32_bf16(a, Bf[1][ks], acc[m][1], 0, 0, 0);
                    if (ks == 3 && (m & 1)) __builtin_amdgcn_sched_barrier(0); }
            const float4 lcv = ((const float4*)(p.ws + OFF_LC))[dir * 1024 + ch];
            const float c8sp = lcv.x, nba = lcv.y, nbx = lcv.z;
            LAS unsigned char* xv_l = xc + (rbase + rsgn * 4 * fq) * TS + chl * 2;
#pragma unroll
            for (int m = 0; m < 8; ++m) {
#pragma unroll
                for (int h = 0; h < 2; ++h) {
                    typedef float f2 __attribute__((ext_vector_type(2)));
                    const f2 za = {acc[m][0][2 * h], acc[m][0][2 * h + 1]}, zx = {acc[m][1][2 * h], acc[m][1][2 * h + 1]};
                    const f2 ta = za * (-1.4426950408889634f) + nba, tx = zx * (-1.4426950408889634f) + nbx;
                    f2 ea, ex; ea.x = __builtin_amdgcn_exp2f(ta.x); ea.y = __builtin_amdgcn_exp2f(ta.y); ex.x = __builtin_amdgcn_exp2f(tx.x); ex.y = __builtin_amdgcn_exp2f(tx.y);
                    ea = ea + 1.0f; ex = ex + 1.0f;
                    f2 r, ig; r.x = __builtin_amdgcn_rcpf(ea.x); r.y = __builtin_amdgcn_rcpf(ea.y); ig.x = __builtin_amdgcn_rcpf(ex.x); ig.y = __builtin_amdgcn_rcpf(ex.y);
                    const f2 la = r * (-c8sp); f2 a; a.x = __builtin_amdgcn_exp2f(la.x); a.y = __builtin_amdgcn_exp2f(la.y);
                    const f2 om = 1.0f - a * a; f2 mult; mult.x = __builtin_amdgcn_sqrtf(om.x); mult.y = __builtin_amdgcn_sqrtf(om.y);
                    f2 xv; xv.x = bf2f((unsigned)*(LAS bf16_t*)(xv_l + rsgn * ((m * 16 + 2 * h) * TS))); xv.y = bf2f((unsigned)*(LAS bf16_t*)(xv_l + rsgn * ((m * 16 + 2 * h + 1) * TS)));
                    const f2 b = mult * ig * xv;
                    acc[m][0][2 * h] = a.x; acc[m][0][2 * h + 1] = a.y; acc[m][1][2 * h] = b.x; acc[m][1][2 * h + 1] = b.y; }
                if (m & 1) __builtin_amdgcn_sched_barrier(0); }
            float Pt, Ht;
            lru_scan(acc, lane, fq, Pt, Ht);
            if (fq == 0) agg[(size_t)(cidx * 2 + dir) * 1024 + ch] = make_float2(Pt, Ht);
            LAS unsigned char* pp_l = pl + dir * (128 * TS) + (rbase + rsgn * 4 * fq) * TS + chl * 2;
            LAS unsigned char* s0_l = raw + (rbase + rsgn * 4 * fq) * TS + chl * 2;
#pragma unroll
            for (int m = 0; m < 8; ++m)
#pragma unroll
                for (int i = 0; i < 4; ++i) { const int ro = rsgn * ((m * 16 + i) * TS);
                    *(LAS bf16_t*)(pp_l + ro) = f2bf_hw(acc[m][1][i]);
                    LAS bf16_t* q = (LAS bf16_t*)(s0_l + ro);
                    *q = f2bf_hw(dir == 0 ? acc[m][0][i] : acc[m][0][i] + bf2f((unsigned)*q)); }
        }
        __syncthreads();
#pragma unroll 1
        for (int it = 0; it < 4; ++it) { const int idx = tid + it * 512, t = idx >> 4, v = idx & 15; const size_t go = (size_t)(tok0 + t) * 1024 + hd * 128 + v * 8;
            *(u32x4v*)(S0g + go) = *(LAS u32x4v*)(raw + t * TS + v * 16);
            *(u32x4v*)(Pfg + go) = *(LAS u32x4v*)(pl + t * TS + v * 16);
            *(u32x4v*)(Pbg + go) = *(LAS u32x4v*)(pl + 128 * TS + t * TS + v * 16); }
        __syncthreads();
    }
}
__device__ __forceinline__ void lru_out_phase(const Params& p) {
    bf16_t* S0g = (bf16_t*)p.out; const bf16_t* Pfg = (const bf16_t*)p.out + (size_t)NTOK * 1024; const bf16_t* Pbg = (const bf16_t*)(p.ws + REG(5));
    const bf16_t* ya = (const bf16_t*)(p.ws + REG(1)); const float* car = (const float*)(p.ws + OFF_CAR);
    for (int idx0 = blockIdx.x * 512 + threadIdx.x; idx0 < NTOK * 128; idx0 += gridDim.x * 1024) {
        u32x4v s[2], pf[2], pb[2], y[2]; size_t go[2];
#pragma unroll
        for (int r = 0; r < 2; ++r) { int idx = idx0 + r * gridDim.x * 512; if (idx >= NTOK * 128) idx = idx0; const int tok = idx >> 7, c0 = (idx & 127) * 8; go[r] = (size_t)tok * 1024 + c0;
            s[r] = *(const u32x4v*)(S0g + go[r]); pf[r] = *(const u32x4v*)(Pfg + go[r]); pb[r] = *(const u32x4v*)(Pbg + go[r]); y[r] = *(const u32x4v*)(ya + go[r]); }
#pragma unroll
        for (int r = 0; r < 2; ++r) { int idx = idx0 + r * gridDim.x * 512; if (idx >= NTOK * 128) { if (r) break; idx = idx0; } const int tok = idx >> 7, c0 = (idx & 127) * 8, cidx = tok >> 7;
            const float4 cf0 = *(const float4*)(car + (size_t)(cidx * 2) * 1024 + c0), cf1 = *(const float4*)(car + (size_t)(cidx * 2) * 1024 + c0 + 4);
            const float4 cb0 = *(const float4*)(car + (size_t)(cidx * 2 + 1) * 1024 + c0), cb1 = *(const float4*)(car + (size_t)(cidx * 2 + 1) * 1024 + c0 + 4);
            u32x4v o;
#define LO_E(S, PF, PB, Y, CF, CB, FN) ((FN(S) + FN(PF) * (CF) + FN(PB) * (CB)) * gelu_t(FN(Y)))
            o.x = cvt_pk_bf16(LO_E(s[r].x, pf[r].x, pb[r].x, y[r].x, cf0.x, cb0.x, bflo), LO_E(s[r].x, pf[r].x, pb[r].x, y[r].x, cf0.y, cb0.y, bfhi));
            o.y = cvt_pk_bf16(LO_E(s[r].y, pf[r].y, pb[r].y, y[r].y, cf0.z, cb0.z, bflo), LO_E(s[r].y, pf[r].y, pb[r].y, y[r].y, cf0.w, cb0.w, bfhi));
            o.z = cvt_pk_bf16(LO_E(s[r].z, pf[r].z, pb[r].z, y[r].z, cf1.x, cb1.x, bflo), LO_E(s[r].z, pf[r].z, pb[r].z, y[r].z, cf1.y, cb1.y, bfhi));
            o.w = cvt_pk_bf16(LO_E(s[r].w, pf[r].w, pb[r].w, y[r].w, cf1.z, cb1.z, bflo), LO_E(s[r].w, pf[r].w, pb[r].w, y[r].w, cf1.w, cb1.w, bfhi));
            *(u32x4v*)(S0g + go[r]) = o; }
    }
}

__device__ __forceinline__ void carry_phase(const Params& p) {
    const float2* agg = (const float2*)(p.ws + OFF_AGG); float* car = (float*)(p.ws + OFF_CAR);
    for (int i = blockIdx.x * 512 + threadIdx.x; i < 18 * 2 * 1024; i += gridDim.x * 512) {
        const int ch = i & 1023, dir = (i >> 10) & 1, seq = i >> 11;
        const int c0 = seq < 16 ? seq * 32 : 512 + (seq - 16) * 64, nc = seq < 16 ? 32 : 64;
        float c = 0.f;
#pragma unroll 16
        for (int j = 0; j < nc; ++j) { const int ci = c0 + (dir == 0 ? j : nc - 1 - j); const size_t o = (size_t)(ci * 2 + dir) * 1024 + ch; const float2 a = agg[o]; car[o] = c; c = a.x * c + a.y; }
    }
}

__device__ __forceinline__ u32x2v tr_read(unsigned addr) { u32x2v r; asm volatile("ds_read_b64_tr_b16 %0, %1\n\ts_waitcnt lgkmcnt(0)" : "=&v"(r) : "v"(addr) : "memory"); return r; }

template <int MT, int K, int STEP>
__device__ __forceinline__ void dft_tile(const Params& p, LAS unsigned char* Al, LAS unsigned char* Dl, int seqtok, int S, int N2, int n0, int k1) {
    const int tid = threadIdx.x, lane = tid & 63, w = tid >> 6, fr = lane & 15, fq = lane >> 4;
    constexpr int KS = K / 32, MB = MT / 16, AST = 2 * K + 16;
    const bf16_t* src0 = STEP == 1 ? (const bf16_t*)(p.ws + REG(4)) + (size_t)seqtok * 1024 + n0
                                   : (const bf16_t*)(p.ws + REG(0)) + (size_t)seqtok * 1024 + (size_t)(2 * k1) * N2 * 384 + n0;
#pragma unroll
    for (int it = 0; it < K * 16 / 512; ++it) { const int idx = tid + it * 512, kk = idx >> 4, v = idx & 15;
        size_t ro;
        if (STEP == 1) { const int part = kk >> 6, s1 = kk & 63; ro = (size_t)part * S * 384 + (size_t)(s1 * N2) * 384; }
        else { const int part = kk / (K / 2), s2 = kk % (K / 2); ro = (size_t)part * N2 * 384 + (size_t)s2 * 384; }
        *(LAS u32x4v*)(Dl + kk * 288 + v * 16) = *(const u32x4v*)(src0 + ro + v * 8); }
    __syncthreads();
    bf16x8 Bf[KS];
    { const int q = fr >> 2, pp = fr & 3; const unsigned base = (unsigned)(size_t)Dl + (unsigned)((4 * fq + q) * 288 + (16 * w + 4 * pp) * 2);
#pragma unroll
        for (int ks = 0; ks < KS; ++ks) { const u32x2v r0 = tr_read(base + (unsigned)((32 * ks) * 288)), r1 = tr_read(base + (unsigned)((32 * ks + 16) * 288));
            u32x4v t; t.x = r0.x; t.y = r0.y; t.z = r1.x; t.w = r1.y; Bf[ks] = __builtin_bit_cast(bf16x8, t); } }
    f32x4 acc[MB];
#pragma unroll
    for (int mb = 0; mb < MB; ++mb) { acc[mb] = (f32x4){0.f, 0.f, 0.f, 0.f};
#pragma unroll
        for (int ks = 0; ks < KS; ++ks) { const bf16x8 a = *(LAS bf16x8*)(Al + (16 * mb + fr) * AST + (32 * ks + 8 * fq) * 2);
            acc[mb] = __builtin_amdgcn_mfma_f32_16x16x32_bf16(a, Bf[ks], acc[mb], 0, 0, 0); } }
    const int n = n0 + 16 * w + fr;
    if (STEP == 1) {
        const float2* tw = (const float2*)(p.ws + (S == 4096 ? OFF_TW4 : OFF_TW8)); const int s2 = n / 384;
        bf16_t* o = (bf16_t*)(p.ws + REG(0)) + (size_t)seqtok * 1024 + n; const size_t rstr = (size_t)N2 * 384;
#pragma unroll
        for (int mb = 0; mb < MB; ++mb)
#pragma unroll
            for (int ii = 0; ii < 2; ++ii) { const int kk1 = 8 * mb + 2 * fq + ii; const float2 cs = tw[kk1 * s2]; const float re = acc[mb][2 * ii], im = acc[mb][2 * ii + 1];
                o[(size_t)(2 * kk1) * rstr] = f2bf(re * cs.x + im * cs.y); o[(size_t)(2 * kk1 + 1) * rstr] = f2bf(im * cs.x - re * cs.y); }
    } else {
        const int g = n / 96, mm = n - 96 * g; const float scale = rsqrtf((float)S * 128.0f);
        bf16_t* o = (bf16_t*)(p.ws + REG(4)) + (size_t)seqtok * 512 + g * 128;
#pragma unroll
        for (int mb = 0; mb < MB; ++mb)
#pragma unroll
            for (int i = 0; i < 4; ++i) { const int k2 = 16 * mb + 4 * fq + i, k = k1 + 64 * k2; const bf16_t v = f2bf(acc[mb][i] * scale);
                if (mm <= 64) o[(size_t)k * 512 + mm] = v;
                if (mm >= 1 && mm <= 63) o[(size_t)((S - k) & (S - 1)) * 512 + 128 - mm] = v; }
    }
    __syncthreads();
}
__device__ __forceinline__ void dft_loadA(LAS unsigned char* Al, const bf16_t* Ag, int MT, int K) {
    const int vpr = K / 8, total = MT * vpr;
    for (int idx = threadIdx.x; idx < total; idx += 512) { const int r = idx / vpr, v = idx % vpr; *(LAS u32x4v*)(Al + r * (2 * K + 16) + v * 16) = *(const u32x4v*)(Ag + (size_t)r * K + v * 8); }
}
__device__ __forceinline__ void dft_phase(const Params& p, LAS unsigned char* lds, int step) {
    LAS unsigned char* Al = lds; LAS unsigned char* Dl = lds + 67584;
    int curA = -1;
    if (step == 1) {
        dft_loadA(Al, (const bf16_t*)(p.ws + OFF_DA1), 128, 128);
        for (int tile = blockIdx.x; tile < 3840; tile += gridDim.x) {
            int seq, ti, S, N2; if (tile < 768) { seq = 16 + tile / 384; ti = tile % 384; S = 8192; N2 = 128; } else { const int t2 = tile - 768; seq = t2 / 192; ti = t2 % 192; S = 4096; N2 = 64; }
            const int seqtok = seq < 16 ? seq * 4096 : NPR + (seq - 16) * 8192;
            dft_tile<128, 128, 1>(p, Al, Dl, seqtok, S, N2, ti * 128, 0);
        }
    } else {
        for (int tile = blockIdx.x; tile < 3456; tile += gridDim.x) {
            if (tile < 384) { const int seq = 16 + tile / 192, r = tile % 192, k1 = r / 3, n0 = (r % 3) * 128;
                if (curA != 2) { __syncthreads(); dft_loadA(Al, (const bf16_t*)(p.ws + OFF_DA3L), 128, 256); curA = 2; }
                dft_tile<128, 256, 3>(p, Al, Dl, NPR + (seq - 16) * 8192, 8192, 128, n0, k1);
            } else { const int t2 = tile - 384, seq = t2 / 192, r = t2 % 192, k1 = r / 3, n0 = (r % 3) * 128;
                if (curA != 1) { __syncthreads(); dft_loadA(Al, (const bf16_t*)(p.ws + OFF_DA3S), 64, 128); curA = 1; }
                dft_tile<64, 128, 3>(p, Al, Dl, seq * 4096, 4096, 64, n0, k1);
            }
        }
    }
    __syncthreads();
}

typedef float f32x2v __attribute__((ext_vector_type(2)));
__device__ __forceinline__ f32x2v up2(unsigned v) { f32x2v r; r.x = __uint_as_float(v << 16); r.y = __uint_as_float(v & 0xffff0000u); return r; }
__device__ __forceinline__ void unpack8v(const u32x4v v, f32x2v (&f)[4]) { f[0] = up2(v.x); f[1] = up2(v.y); f[2] = up2(v.z); f[3] = up2(v.w); }
__device__ __forceinline__ f32x2v gelu2(f32x2v x) {
    const f32x2v u = x * (x * x * (-0.10294324f) + (-2.3022082f));
    f32x2v e; e.x = __builtin_amdgcn_exp2f(u.x); e.y = __builtin_amdgcn_exp2f(u.y);
    const f32x2v d = e + 1.0f; f32x2v r; r.x = __builtin_amdgcn_rcpf(d.x); r.y = __builtin_amdgcn_rcpf(d.y);
    return x * r;
}
__device__ __forceinline__ void convgelu_phase(const Params& p, int row0, int nrows) {
    constexpr int PC = 5632; const bf16_t* up = (const bf16_t*)(p.ws + REG(1)); bf16_t* gout = (bf16_t*)(p.ws + REG(3));
    const int total = (nrows / 32) * 22 * 16;
    for (int idx = blockIdx.x * 512 + threadIdx.x; idx < total; idx += gridDim.x * 512) {
        const int v = idx & 15, q = idx >> 4, nl = q % 22, run = q / 22, j0 = 128 * nl + 8 * v, tl = run * 32, t0 = row0 + tl;
        int S, s0; if (t0 < NPR) { S = 4096; s0 = t0 & 4095; } else { S = 8192; s0 = (t0 - NPR) & 8191; }
        f32x2v wv[3][4], wg[3][4], bv[4], bg[4];
#pragma unroll
        for (int e = 0; e < 4; ++e) { bv[e] = *(const f32x2v*)(p.ffn_conv_b + j0 + 2 * e); bg[e] = *(const f32x2v*)(p.ffn_conv_b + 2816 + j0 + 2 * e);
#pragma unroll
            for (int k = 0; k < 3; ++k) { wv[k][e] = *(const f32x2v*)(p.ffn_conv_w + k * 5632 + j0 + 2 * e); wg[k][e] = *(const f32x2v*)(p.ffn_conv_w + k * 5632 + 2816 + j0 + 2 * e); } }
        const bf16_t* base = up + (size_t)tl * PC + nl * 256 + 8 * v;
        f32x2v av[4], ag[4], bvf[4], bgf[4];
        { u32x4v a0 = {0u, 0u, 0u, 0u}, a1 = {0u, 0u, 0u, 0u};
          if (s0 > 0) { a0 = *(const u32x4v*)(base - PC); a1 = *(const u32x4v*)(base - PC + 128); }
          unpack8v(a0, av); unpack8v(a1, ag); unpack8v(*(const u32x4v*)(base), bvf); unpack8v(*(const u32x4v*)(base + 128), bgf); }
#pragma unroll 8
        for (int tt = 0; tt < 32; ++tt) {
            u32x4v c0 = {0u, 0u, 0u, 0u}, c1 = {0u, 0u, 0u, 0u};
            if (s0 + tt + 1 < S) { c0 = *(const u32x4v*)(base + (size_t)(tt + 1) * PC); c1 = *(const u32x4v*)(base + (size_t)(tt + 1) * PC + 128); }
            f32x2v cvf[4], cgf[4], o[4]; unpack8v(c0, cvf); unpack8v(c1, cgf);
#pragma unroll
            for (int e = 0; e < 4; ++e) { const f32x2v ov = wv[2][e] * cvf[e] + (wv[1][e] * bvf[e] + (wv[0][e] * av[e] + bv[e]));
                const f32x2v og = wg[2][e] * cgf[e] + (wg[1][e] * bgf[e] + (wg[0][e] * ag[e] + bg[e]));
                o[e] = gelu2(og) * ov; av[e] = bvf[e]; ag[e] = bgf[e]; bvf[e] = cvf[e]; bgf[e] = cgf[e]; }
            u32x4v ov4; ov4.x = cvt_pk_bf16(o[0].x, o[0].y); ov4.y = cvt_pk_bf16(o[1].x, o[1].y); ov4.z = cvt_pk_bf16(o[2].x, o[2].y); ov4.w = cvt_pk_bf16(o[3].x, o[3].y);
            *(u32x4v*)(gout + (size_t)(t0 + tt) * 2816 + j0) = ov4;
        }
    }
}

constexpr int N_PHASES = 20;
#ifndef PH_MASK
#define PH_MASK 0xFFFFFFFFu
#endif
#define EN(n) ((PH_MASK >> (n)) & 1u)
#ifndef ONE_LAUNCH
#define ONE_LAUNCH 1
#endif
#define XB_TMO      128
#define XB_XCNT(j)  (256  + 64 * (j))
#define XB_XSUB(j)  (1280 + 64 * (j))
#define XB_XGEN(j)  (2304 + 64 * (j))
#define XB_TOP      3328
#define XB_TOPGEN   3392
#define XCD_BAR_WORDS 3456
#define XB_SPIN_CAP (1u << 18)

__device__ __forceinline__ unsigned xb_ld(unsigned* p)              { return __hip_atomic_load(p, __ATOMIC_RELAXED, __HIP_MEMORY_SCOPE_AGENT); }
__device__ __forceinline__ unsigned xb_add(unsigned* p, unsigned v) { return __hip_atomic_fetch_add(p, v, __ATOMIC_RELAXED, __HIP_MEMORY_SCOPE_AGENT); }
__device__ __forceinline__ unsigned xb_xcc_id() { return (unsigned)__builtin_amdgcn_s_getreg((3 << 11) | 20) & 0xFu; }
#define XB_SPIN(cond, bar) do { unsigned _sp = 0; while (cond) { __builtin_amdgcn_s_sleep(1); \
    if ((++_sp & 255u) == 0u) { if (xb_ld(&(bar)[XB_TMO])) break; if (_sp > XB_SPIN_CAP) { atomicAdd(&(bar)[XB_TMO], 1u); break; } } } } while (0)

struct XcdBarrier {
    unsigned* bar; unsigned x;
    volatile LAS unsigned* st;
};

__device__ __forceinline__ XcdBarrier xcd_barrier_post(unsigned* bar, volatile LAS unsigned* st) {
    XcdBarrier b; b.bar = bar; b.x = xb_xcc_id(); b.st = st;
    if (threadIdx.x == 0) (void)xb_add(&bar[XB_XCNT(b.x)], 1u);
    return b;
}
__device__ __forceinline__ void xcd_barrier_complete(unsigned* bar, unsigned x, unsigned& nloc, unsigned& nx) {
    const unsigned G = gridDim.x * gridDim.y * gridDim.z;
    unsigned sum, cnt, mine, sp = 0u;
    for (;;) {
        sum = 0u; cnt = 0u; mine = 0u;
#pragma unroll
        for (unsigned j = 0; j < 16; ++j) { const unsigned c = xb_ld(&bar[XB_XCNT(j)]); sum += c; cnt += (c > 0u) ? 1u : 0u; mine = (j == x) ? c : mine; }
        if (sum == G) break;
        __builtin_amdgcn_s_sleep(1);
        if ((++sp & 255u) == 0u) { if (xb_ld(&bar[XB_TMO])) break; if (sp > XB_SPIN_CAP) { atomicAdd(&bar[XB_TMO], 1u); break; } }
    }
    nloc = mine > 0u ? mine : 1u; nx = cnt > 0u ? cnt : 1u;
}

__device__ __forceinline__ void xcd_barrier(const XcdBarrier& b) {
    asm volatile("s_waitcnt vmcnt(0)" ::: "memory");
    __syncthreads();
    if (threadIdx.x == 0) {
        unsigned* bar = b.bar;
        __builtin_amdgcn_s_waitcnt(0);
        unsigned nloc = b.st[0], nx = b.st[1];
        if (nloc == 0u) { xcd_barrier_complete(bar, b.x, nloc, nx); b.st[0] = nloc; b.st[1] = nx; }
        const unsigned old = xb_add(&bar[XB_XSUB(b.x)], 1u);
        const unsigned gen = old / nloc;
        if (old + 1u == (gen + 1u) * nloc) {
            __builtin_amdgcn_fence(__ATOMIC_RELEASE, "agent");
            asm volatile("s_waitcnt vmcnt(0)" ::: "memory");
            const unsigned og = xb_add(&bar[XB_TOP], 1u);
            const unsigned tg = og / nx;
            if (og + 1u == (tg + 1u) * nx) xb_add(&bar[XB_TOPGEN], 1u);
            else XB_SPIN(xb_ld(&bar[XB_TOPGEN]) == tg, bar);
            __builtin_amdgcn_fence(__ATOMIC_ACQUIRE, "agent");
            xb_add(&bar[XB_XGEN(b.x)], 1u);
            asm volatile("s_waitcnt vmcnt(0)" ::: "memory");
        } else {
            XB_SPIN(xb_ld(&bar[XB_XGEN(b.x)]) == gen, bar);
            __builtin_amdgcn_fence(__ATOMIC_ACQUIRE, "agent");
            asm volatile("s_waitcnt vmcnt(0)" ::: "memory");
        }
    }
    __syncthreads();
}


__device__ __forceinline__ void grid_bar(unsigned* ctr, unsigned target) {
    __syncthreads();
    if (threadIdx.x == 0) {
        __builtin_amdgcn_fence(__ATOMIC_RELEASE, "agent");
        __hip_atomic_fetch_add(ctr, 1u, __ATOMIC_RELAXED, __HIP_MEMORY_SCOPE_AGENT);
        while (__hip_atomic_load(ctr, __ATOMIC_RELAXED, __HIP_MEMORY_SCOPE_AGENT) < target) __builtin_amdgcn_s_sleep(2);
        __builtin_amdgcn_fence(__ATOMIC_ACQUIRE, "agent");
        asm volatile("s_waitcnt vmcnt(0)" ::: "memory");
    }
    __syncthreads();
}
template <int PH> __device__ __forceinline__ void run_phase(const Params& p, LAS unsigned char* lds) {
    unsigned char* ws = p.ws;
    if constexpr (PH == 0) { if (EN(0)) prep_phase(p, lds); }
    else if constexpr (PH == 1) { if (EN(1)) h1_phase(p); }
    else if constexpr (PH == 2) { if (EN(2)) { EpiIn E; E.ws = ws; run_gemm(lds, (const bf16_t*)p.out, (const bf16_t*)(ws + OFF_WIN), NTOK, 4864, 1024, E); }
#ifdef PROBE_NULLGEMM
        __syncthreads(); { EpiNull E; E.sink = (float*)(ws + OFF_ST1); run_gemm_same(lds, (const bf16_t*)p.out, (const bf16_t*)(ws + OFF_WIN), NTOK, 5120, 1024, E); }
#endif
    }
    else if constexpr (PH == 3) { if (EN(3)) lru_phase(p, lds); }
    else if constexpr (PH == 4) { if (EN(4)) carry_phase(p); if (EN(18)) dft_phase(p, lds, 1); }
    else if constexpr (PH == 5) { if (EN(5)) lru_out_phase(p); if (EN(19)) dft_phase(p, lds, 3); }
    else if constexpr (PH == 6) { if (EN(6)) { EpiGateA E; E.G = (const bf16_t*)(ws + REG(2)); E.T = (bf16_t*)(ws + REG(0)); run_gemm(lds, (const bf16_t*)p.out, (const bf16_t*)(ws + OFF_WA), NTOK, 1024, 1024, E); }
        __syncthreads();
        if (EN(7)) { EpiGateB E; E.G = (const bf16_t*)(ws + REG(3)); E.T = (bf16_t*)(ws + REG(0)); run_gemm(lds, (const bf16_t*)(ws + REG(4)), (const bf16_t*)(ws + OFF_WB), NTOK, 1024, 512, E); } }
    else if constexpr (PH == 7) { }
    else if constexpr (PH == 8) { if (EN(8)) { EpiStat E; E.O = (bf16_t*)(ws + REG(2)); E.stat = (float*)(ws + OFF_ST1); run_gemm(lds, (const bf16_t*)(ws + REG(0)), (const bf16_t*)(ws + OFF_WO), NTOK, 1024, 1024, E); } }
    else if constexpr (PH == 9) { if (EN(9)) x1_phase(p); }
    else if constexpr (PH == 10 || PH == 12 || PH == 14 || PH == 16) { if (EN(10)) { constexpr int part = (PH - 10) >> 1, row0 = part * 20480;
        EpiUp E; E.O = (bf16_t*)(ws + REG(1)); E.ld = 5632; run_gemm(lds, (const bf16_t*)(ws + REG(0)) + (size_t)row0 * 1024, (const bf16_t*)(ws + OFF_WUP), 20480, 5632, 1024, E); } }
    else if constexpr (PH == 11 || PH == 13 || PH == 15 || PH == 17) { if (EN(11)) { constexpr int part = (PH - 11) >> 1; convgelu_phase(p, part * 20480, 20480); } }
    else if constexpr (PH == 18) { if (EN(16)) { EpiStat E; E.O = (bf16_t*)(ws + REG(1)); E.stat = (float*)(ws + OFF_ST2); run_gemm(lds, (const bf16_t*)(ws + REG(3)), (const bf16_t*)(ws + OFF_WD), NTOK, 1024, 2816, E); } }
    else if constexpr (PH == 19) { if (EN(17)) final_phase(p); }
}
__global__ void __launch_bounds__(512, 2) mega_kernel(Params p) {
    extern __shared__ __attribute__((aligned(16))) unsigned char shm[];
    LAS unsigned char* lds = (LAS unsigned char*)shm;
#if ONE_LAUNCH
    cg::grid_group grid = cg::this_grid();
    volatile LAS unsigned* st = (volatile LAS unsigned*)(lds + LDS_BYTES - 16);
    if (threadIdx.x == 0) { st[0] = 0u; st[1] = 0u; }
    __syncthreads();
    const XcdBarrier xb = xcd_barrier_post((unsigned*)(p.ws + OFF_BAR), st);
#ifndef REPEAT_MASK
#define REPEAT_MASK 0u
#endif
#define PHS(n, k) run_phase<n>(p, lds); if ((REPEAT_MASK >> (n)) & 1u) { xcd_barrier(xb); run_phase<n>(p, lds); } xcd_barrier(xb);
    if (p.ph_hi < 0) grid.sync();
    run_phase<0>(p, lds); xcd_barrier(xb);
    PHS(1, 1) PHS(2, 2) PHS(3, 3) PHS(4, 4) PHS(5, 5) PHS(6, 6) PHS(8, 8) PHS(9, 9) PHS(10, 10) PHS(11, 11) PHS(12, 12) PHS(13, 13) PHS(14, 14) PHS(15, 15) PHS(16, 16) PHS(17, 17) PHS(18, 18)
    run_phase<19>(p, lds);
#else
#define PHC(n) case n: run_phase<n>(p, lds); break;
    switch (p.ph_lo) { PHC(0) PHC(1) PHC(2) PHC(3) PHC(4) PHC(5) PHC(6) PHC(7) PHC(8) PHC(9) PHC(10) PHC(11) PHC(12) PHC(13) PHC(14) PHC(15) PHC(16) PHC(17) PHC(18) PHC(19) }
#endif
}

extern "C" void kernel_launch(void* const* d_in, const int* in_sizes, int n_in, void* d_out, int out_size, void* d_ws, size_t ws_size, hipStream_t stream) {
    static int grid = 0;
    if (grid == 0) {
        if (ws_size < OFF_BIG + 6 * REG_BYTES) { fprintf(stderr, "kernel_launch: workspace too small (%zu)\n", ws_size); grid = -1; return; }
        int dev = 0, cus = 0, per_cu = 0;
        hipGetDevice(&dev); hipDeviceGetAttribute(&cus, hipDeviceAttributeMultiprocessorCount, dev);
        if (hipFuncSetAttribute((const void*)mega_kernel, hipFuncAttributeMaxDynamicSharedMemorySize, LDS_BYTES) != hipSuccess) { fprintf(stderr, "kernel_launch: hipFuncSetAttribute failed\n"); grid = -1; return; }
        if (hipOccupancyMaxActiveBlocksPerMultiprocessor(&per_cu, (const void*)mega_kernel, 512, LDS_BYTES) != hipSuccess || per_cu < 1) { fprintf(stderr, "kernel_launch: occupancy query gave %d\n", per_cu); per_cu = 1; }
        (void)hipGetLastError();
        grid = cus * per_cu;
    }
    if (grid < 0) return;
    Params p{};
    const float** pp = (const float**)&p;
    for (int i = 0; i < 25; ++i) pp[i] = (const float*)d_in[i];
    p.out = (float*)d_out; p.ws = (unsigned char*)d_ws;
#if ONE_LAUNCH
    p.ph_lo = 0; p.ph_hi = N_PHASES;
    (void)hipMemsetAsync((unsigned char*)d_ws + OFF_BAR, 0, 16384, stream);
    void* args[] = {&p};
    hipError_t e = hipLaunchCooperativeKernel((const void*)mega_kernel, dim3(grid), dim3(512), args, LDS_BYTES, stream);
    if (e != hipSuccess) fprintf(stderr, "cooperative launch failed: %s (grid %d)\n", hipGetErrorString(e), grid);
#else
    for (int ph = 0; ph < N_PHASES; ++ph) { p.ph_lo = ph; p.ph_hi = ph + 1; hipLaunchKernelGGL(mega_kernel, dim3(grid), dim3(512), LDS_BYTES, stream, p); }
#endif
}
```
